# Optimizing an MI355X kernel written in HIP

```python
import math
import jax, jax.numpy as jnp
from jax import lax
import numpy as np

D_MODEL = 1024
BATCH = 4
SEQ = 4096
DEPTH = 2

N_A_LAYERS = (DEPTH + 1) // 2
N_B_LAYERS = DEPTH // 2

CHUNK = 64
Q_BLOCK = 128
MEM_LEN = 256
MIX_W = D_MODEL
MEM_W = D_MODEL // 4
MEM_HEADS = 4
MEM_HD = MEM_W // MEM_HEADS
TOK_W = MIX_W - MEM_W
DA_DH = 64
DA_HEADS = TOK_W // (2 * DA_DH)
DA_IN = 3 * TOK_W + MEM_W
SSM_HD = 64
SSM_HEADS = TOK_W // SSM_HD
SSM_GROUPS = 2
SSM_STATE = 128
SSM_CONV_K = 4
SSM_CONV_DIM = TOK_W + 2 * SSM_GROUPS * SSM_STATE
SSM_IN = TOK_W + SSM_CONV_DIM + SSM_HEADS + MEM_W
FFN_DIM = 128 * ((8 * D_MODEL // 3 + 127) // 128)
N_EXPERTS = 8
TOP_K = 2
EXPERT_DIM = 7 * D_MODEL // 2
EPS = 1e-6

kernel_name = "hybrid_diffattn_ssd_moe_streaming"


def rms_norm(x, g):
    xf = x.astype(jnp.float32)
    y = xf * lax.rsqrt(jnp.mean(xf * xf, axis=-1, keepdims=True) + EPS)
    return (y * g.astype(jnp.float32)).astype(x.dtype)


def swiglu(h, w_gate, w_up, w_down):
    return (jax.nn.silu(h @ w_gate) * (h @ w_up)) @ w_down


def diff_attention(q, k, v, qn_g, kn_g, lam, sub_g, lambda_init):
    b, s = q.shape[:2]
    q = rms_norm(q, qn_g)
    k = rms_norm(k, kn_g)
    scale = DA_DH ** -0.5
    nqb = s // Q_BLOCK
    q_blocks = jnp.swapaxes(q.reshape(b, nqb, Q_BLOCK, DA_HEADS, 2, DA_DH), 0, 1)
    pos_chunk = jnp.arange(s) // CHUNK
    q_chunk = pos_chunk.reshape(nqb, Q_BLOCK)

    def one_block(args):
        q_blk, qc = args
        sc = jnp.einsum('bqhid,bkhid->bhiqk', q_blk, k).astype(jnp.float32) * scale
        mask = pos_chunk[None, :] <= qc[:, None]
        sc = jnp.where(mask, sc, -jnp.inf)
        p = jax.nn.softmax(sc, axis=-1)
        a = p[:, :, 0] - lam * p[:, :, 1]
        return jnp.einsum('bhqk,bkhe->bqhe', a.astype(v.dtype), v)

    o = lax.map(one_block, (q_blocks, q_chunk))
    o = jnp.swapaxes(o, 0, 1).reshape(b, s, DA_HEADS, 2 * DA_DH)
    o = rms_norm(o, sub_g) * (1.0 - lambda_init)
    return o.reshape(b, s, TOK_W)


def memory_attention(mq, mem_n, w_kv, qn_g, kn_g):
    b, s = mq.shape[:2]
    m = mem_n.shape[1]
    q = rms_norm(mq.reshape(b, s, MEM_HEADS, MEM_HD), qn_g)
    kv = mem_n @ w_kv
    k = rms_norm(kv[..., :MEM_W].reshape(b, m, MEM_HEADS, MEM_HD), kn_g)
    v = kv[..., MEM_W:].reshape(b, m, MEM_HEADS, MEM_HD)
    sc = jnp.einsum('bqhd,bkhd->bhqk', q, k).astype(jnp.float32) * (MEM_HD ** -0.5)
    p = jax.nn.softmax(sc, axis=-1)
    o = jnp.einsum('bhqk,bkhd->bqhd', p.astype(v.dtype), v)
    return o.reshape(b, s, MEM_W)


def causal_depthwise_conv(x, w):
    kw, c = w.shape
    return lax.conv_general_dilated(x, w[:, None, :].astype(x.dtype), window_strides=(1,),
                                    padding=[(kw - 1, 0)], dimension_numbers=('NWC', 'WIO', 'NWC'),
                                    feature_group_count=c)


def ssd(x, dt, a, bm, cm):
    b, s, h, p = x.shape
    g, n = bm.shape[2], bm.shape[3]
    hg = h // g
    nc = s // CHUNK
    f32 = jnp.float32
    x = x.astype(f32).reshape(b, nc, CHUNK, g, hg, p)
    dt = dt.reshape(b, nc, CHUNK, g, hg)
    bm = bm.astype(f32).reshape(b, nc, CHUNK, g, n)
    cm = cm.astype(f32).reshape(b, nc, CHUNK, g, n)
    cum = jnp.cumsum(dt * a.reshape(g, hg), axis=2)
    tri = jnp.tril(jnp.ones((CHUNK, CHUNK), dtype=bool))
    seg = cum[:, :, :, None] - cum[:, :, None, :]
    decay = jnp.exp(jnp.where(tri[:, :, None, None], seg, -jnp.inf))
    cb = jnp.einsum('bctgn,bcsgn->bctsg', cm, bm)
    w = cb[..., None] * decay * dt[:, :, None]
    y_diag = jnp.einsum('bctsgh,bcsghp->bctghp', w, x)
    to_end = jnp.exp(cum[:, :, -1:] - cum) * dt
    states = jnp.einsum('bclgn,bclgh,bclghp->bcghpn', bm, to_end, x)
    chunk_decay = jnp.exp(cum[:, :, -1])

    def step(carry, inp):
        st, dec = inp
        return carry * dec[..., None, None] + st, carry

    h0 = jnp.zeros((b, g, hg, p, n), f32)
    _, h_in = lax.scan(step, h0, (jnp.moveaxis(states, 1, 0), jnp.moveaxis(chunk_decay, 1, 0)))
    h_in = jnp.moveaxis(h_in, 0, 1)
    y_off = jnp.einsum('bclgn,bcghpn,bclgh->bclghp', cm, h_in, jnp.exp(cum))
    return (y_diag + y_off).reshape(b, s, h, p)


def mamba2_mixer(z, xbc, dt_raw, conv_w, conv_b, dt_bias, a_log, d_skip, norm_g):
    b, s = z.shape[:2]
    xbc = jax.nn.silu(causal_depthwise_conv(xbc, conv_w) + conv_b)
    xs = xbc[..., :TOK_W].reshape(b, s, SSM_HEADS, SSM_HD)
    bm = xbc[..., TOK_W:TOK_W + SSM_GROUPS * SSM_STATE].reshape(b, s, SSM_GROUPS, SSM_STATE)
    cm = xbc[..., TOK_W + SSM_GROUPS * SSM_STATE:].reshape(b, s, SSM_GROUPS, SSM_STATE)
    dt = jax.nn.softplus(dt_raw.astype(jnp.float32) + dt_bias.astype(jnp.float32))
    a = -jnp.exp(a_log.astype(jnp.float32))
    y = ssd(xs, dt, a, bm, cm)
    y = y + d_skip.astype(jnp.float32)[:, None] * xs.astype(jnp.float32)
    y = y.reshape(b, s, TOK_W) * jax.nn.silu(z.astype(jnp.float32))
    y = rms_norm(y.reshape(b, s, SSM_GROUPS, TOK_W // SSM_GROUPS),
                 norm_g.reshape(SSM_GROUPS, TOK_W // SSM_GROUPS)).reshape(b, s, TOK_W)
    return y.astype(z.dtype)


def moe_swiglu(h, w_router, w_gate, w_up, w_down):
    logits = (h @ w_router).astype(jnp.float32)
    top_val, top_idx = lax.top_k(logits, TOP_K)
    top_w = jax.nn.softmax(top_val, axis=-1)
    gates = jnp.sum(jax.nn.one_hot(top_idx, N_EXPERTS, dtype=jnp.float32) * top_w[..., None], axis=-2)
    out = jnp.zeros(h.shape, jnp.float32)
    for e in range(N_EXPERTS):
        out = out + gates[..., e:e + 1] * swiglu(h, w_gate[e], w_up[e], w_down[e])
    return out.astype(h.dtype)


def setup_inputs(seed: int = 0) -> dict:
    key = jax.random.key(seed)
    ks = iter(jax.random.split(key, 48))
    f32 = jnp.float32

    def nrm(shape, scale):
        return jax.random.normal(next(ks), shape, f32) * scale

    def gain(shape):
        return 1.0 + nrm(shape, 0.02)

    NA, NB = N_A_LAYERS, N_B_LAYERS
    dt0 = jnp.exp(jax.random.uniform(next(ks), (NB, SSM_HEADS), f32,
                                     minval=math.log(1e-3), maxval=math.log(1e-1)))
    dt_bias = dt0 + jnp.log(-jnp.expm1(-dt0))
    a_log = jnp.log(jax.random.uniform(next(ks), (NB, SSM_HEADS), f32, minval=1.0, maxval=16.0))
    return {
        "x": nrm((BATCH, SEQ, D_MODEL), 1.0),
        "mem": nrm((BATCH, MEM_LEN, D_MODEL), 1.0),
        "ln1_g": gain((DEPTH, D_MODEL)),
        "ln2_g": gain((DEPTH, D_MODEL)),
        "mem_norm_g": gain((D_MODEL,)),
        "w_out": nrm((DEPTH, MIX_W, D_MODEL), MIX_W ** -0.5),
        "mem_w_kv": nrm((DEPTH, D_MODEL, 2 * MEM_W), D_MODEL ** -0.5),
        "mem_qn_g": gain((DEPTH, MEM_HD)),
        "mem_kn_g": gain((DEPTH, MEM_HD)),
        "da_w_in": nrm((NA, D_MODEL, DA_IN), D_MODEL ** -0.5),
        "da_qn_g": gain((NA, DA_DH)),
        "da_kn_g": gain((NA, DA_DH)),
        "da_lq1": nrm((NA, DA_DH), 0.1),
        "da_lk1": nrm((NA, DA_DH), 0.1),
        "da_lq2": nrm((NA, DA_DH), 0.1),
        "da_lk2": nrm((NA, DA_DH), 0.1),
        "da_sub_g": gain((NA, 2 * DA_DH)),
        "ssm_w_in": nrm((NB, D_MODEL, SSM_IN), D_MODEL ** -0.5),
        "ssm_conv_w": nrm((NB, SSM_CONV_K, SSM_CONV_DIM), SSM_CONV_K ** -0.5),
        "ssm_conv_b": nrm((NB, SSM_CONV_DIM), 0.02),
        "ssm_dt_bias": dt_bias,
        "ssm_a_log": a_log,
        "ssm_d": gain((NB, SSM_HEADS)),
        "ssm_norm_g": gain((NB, TOK_W)),
        "ffn_w_gate": nrm((NA, D_MODEL, FFN_DIM), D_MODEL ** -0.5),
        "ffn_w_up": nrm((NA, D_MODEL, FFN_DIM), D_MODEL ** -0.5),
        "ffn_w_down": nrm((NA, FFN_DIM, D_MODEL), FFN_DIM ** -0.5),
        "moe_w_router": nrm((NB, D_MODEL, N_EXPERTS), D_MODEL ** -0.5),
        "moe_w_gate": nrm((NB, N_EXPERTS, D_MODEL, EXPERT_DIM), D_MODEL ** -0.5),
        "moe_w_up": nrm((NB, N_EXPERTS, D_MODEL, EXPERT_DIM), D_MODEL ** -0.5),
        "moe_w_down": nrm((NB, N_EXPERTS, EXPERT_DIM, D_MODEL), EXPERT_DIM ** -0.5),
    }


def reference(x, mem, ln1_g, ln2_g, mem_norm_g, w_out, mem_w_kv, mem_qn_g, mem_kn_g,
              da_w_in, da_qn_g, da_kn_g, da_lq1, da_lk1, da_lq2, da_lk2, da_sub_g,
              ssm_w_in, ssm_conv_w, ssm_conv_b, ssm_dt_bias, ssm_a_log, ssm_d, ssm_norm_g,
              ffn_w_gate, ffn_w_up, ffn_w_down,
              moe_w_router, moe_w_gate, moe_w_up, moe_w_down):
    b, s = x.shape[:2]
    mem_n = rms_norm(mem, mem_norm_g)
    for i in range(DEPTH):
        j = i // 2
        h = rms_norm(x, ln1_g[i])
        if i % 2 == 0:
            u = h @ da_w_in[j]
            q = u[..., :TOK_W].reshape(b, s, DA_HEADS, 2, DA_DH)
            k = u[..., TOK_W:2 * TOK_W].reshape(b, s, DA_HEADS, 2, DA_DH)
            v = u[..., 2 * TOK_W:3 * TOK_W].reshape(b, s, DA_HEADS, 2 * DA_DH)
            mq = u[..., 3 * TOK_W:]
            lambda_init = 0.8 - 0.6 * math.exp(-0.3 * i)
            lam = (jnp.exp(jnp.sum(da_lq1[j].astype(jnp.float32) * da_lk1[j].astype(jnp.float32)))
                   - jnp.exp(jnp.sum(da_lq2[j].astype(jnp.float32) * da_lk2[j].astype(jnp.float32)))
                   + lambda_init)
            tok = diff_attention(q, k, v, da_qn_g[j], da_kn_g[j], lam, da_sub_g[j], lambda_init)
        else:
            u = h @ ssm_w_in[j]
            z = u[..., :TOK_W]
            xbc = u[..., TOK_W:TOK_W + SSM_CONV_DIM]
            dt_raw = u[..., TOK_W + SSM_CONV_DIM:TOK_W + SSM_CONV_DIM + SSM_HEADS]
            mq = u[..., TOK_W + SSM_CONV_DIM + SSM_HEADS:]
            tok = mamba2_mixer(z, xbc, dt_raw, ssm_conv_w[j], ssm_conv_b[j], ssm_dt_bias[j],
                               ssm_a_log[j], ssm_d[j], ssm_norm_g[j])
        mo = memory_attention(mq, mem_n, mem_w_kv[i], mem_qn_g[i], mem_kn_g[i])
        mixed = jnp.concatenate([tok.astype(h.dtype), mo.astype(h.dtype)], axis=-1)
        x = x + (mixed @ w_out[i]).astype(x.dtype)
        h = rms_norm(x, ln2_g[i])
        if i % 2 == 0:
            x = x + swiglu(h, ffn_w_gate[j], ffn_w_up[j], ffn_w_down[j]).astype(x.dtype)
        else:
            x = x + moe_swiglu(h, moe_w_router[j], moe_w_gate[j], moe_w_up[j], moe_w_down[j]).astype(x.dtype)
    return x
```

```cpp
#include <hip/hip_runtime.h>
#include <cstdio>
#include <cstdint>

#ifndef MK_LEVEL
#define MK_LEVEL 4
#endif
#ifndef MK_ONE_LAUNCH
#define MK_ONE_LAUNCH 1
#endif


constexpr int NWAVES = 8, NTHREADS = 512;
constexpr int BATCH = 4, SEQ = 4096, DM = 1024, T = BATCH * SEQ;
constexpr int MEM_LEN = 256, MEMROWS = BATCH * MEM_LEN;
constexpr int TOK_W = 768, MEM_W = 256, NPROJ = 2560;
constexpr int DA_HEADS = 6, SSM_HEADS = 12, SSM_CONV = 1280, SSM_IN = 2316;
constexpr int FFN = 2816, EXD = 3584, NEXP = 8;
constexpr int CHUNK = 64, NCH = SEQ / CHUNK;
constexpr float EPS = 1e-6f, LOG2E = 1.4426950408889634f;
constexpr int MOE_MAXTILES = 136;
constexpr int MOE_ROWS = MOE_MAXTILES * 256;

constexpr size_t MiB = 1u << 20;
constexpr size_t WS_CTL = 0, CTL_ZERO_BYTES = 1 * MiB;
constexpr size_t WS_WDA = 1 * MiB;
constexpr size_t WS_WOUT0 = 6 * MiB, WS_WOUT1 = 8 * MiB;
constexpr size_t WS_WKV0 = 10 * MiB, WS_WKV1 = 11 * MiB;
constexpr size_t WS_WSSM = 12 * MiB;
constexpr size_t WS_WGU = 17 * MiB;
constexpr size_t WS_WDN = 28 * MiB;
constexpr size_t WS_WMGU = 34 * MiB;
constexpr size_t WS_R = 146 * MiB;
constexpr size_t WS_XN = WS_R;
constexpr size_t WS_U = WS_R + 32 * MiB;
constexpr size_t WS_MIX = WS_R + 112 * MiB;
constexpr size_t WS_ACT = WS_R + 144 * MiB;
constexpr size_t WS_CONV = WS_R + 144 * MiB;
constexpr size_t WS_STATES = WS_R + 184 * MiB;
constexpr size_t WS_HIN = WS_R + 232 * MiB;
constexpr size_t WS_KVM = WS_R + 280 * MiB;
constexpr size_t WS_MEMN = WS_R + 282 * MiB;
constexpr size_t WS_DT = WS_R + 284 * MiB;
constexpr size_t WS_DTC = WS_R + 285 * MiB;
constexpr size_t WS_CD = WS_R + 287 * MiB;
constexpr size_t WS_HPERM = WS_R;
constexpr size_t WS_ACTM = WS_R + 68 * MiB;
constexpr size_t WS_XNM = WS_R + 274 * MiB;
constexpr size_t WS_ROUTE = WS_R + 306 * MiB;
constexpr size_t WS_GATE = WS_R + 307 * MiB;
constexpr size_t WS_END = WS_R + 308 * MiB;
static_assert(WS_ACTM + (size_t)MOE_ROWS * EXD * 2 <= WS_ROUTE, "ACTM fits");
static_assert(WS_XNM >= WS_HPERM + (size_t)MOE_ROWS * DM * 2 && WS_XNM + (size_t)T * DM * 2 <= WS_ROUTE, "XNM placement");
static_assert(WS_STATES + (size_t)BATCH * NCH * SSM_HEADS * 64 * 128 * 2 <= WS_HIN && WS_HIN + (size_t)BATCH * NCH * SSM_HEADS * 64 * 128 * 2 <= WS_KVM, "STATES/HIN fit");
static_assert(WS_U + (size_t)T * NPROJ * 2 <= WS_MIX && WS_MIX + (size_t)T * DM * 2 <= WS_ACT && WS_ACT + (size_t)T * FFN * 2 <= WS_KVM, "layer-0 map");
static_assert(WS_END <= 468 * MiB, "workspace");

constexpr int CW_BAR = 4096;
constexpr int CW_Q0 = 8192, CW_Q1 = 8256;
constexpr int CW_CNT = 16384;
constexpr int CW_NTILES = 20480;
constexpr int CW_TILE_E = 20544;

constexpr int RING_BYTES = 131072;
constexpr int CONST_OFF = RING_BYTES;
constexpr int MISC_OFF = CONST_OFF + 8192;
constexpr int LDS_BYTES = 147456;

#define GAS __attribute__((address_space(1)))
#define LAS __attribute__((address_space(3)))
typedef unsigned short bf16_t;
typedef short bf16x8 __attribute__((ext_vector_type(8)));
typedef short s16x4 __attribute__((ext_vector_type(4)));
typedef float f32x2 __attribute__((ext_vector_type(2)));
typedef float f32x4 __attribute__((ext_vector_type(4)));
typedef float f32x16 __attribute__((ext_vector_type(16)));
typedef unsigned u32x2 __attribute__((ext_vector_type(2)));
typedef unsigned u32x4 __attribute__((ext_vector_type(4)));
typedef int i32x4 __attribute__((ext_vector_type(4)));
typedef GAS unsigned gu32;
#define RLX_AGENT __ATOMIC_RELAXED, __HIP_MEMORY_SCOPE_AGENT
#define LDS_WAIT() asm volatile("s_waitcnt lgkmcnt(0)" ::: "memory")
#define VM_WAIT() asm volatile("s_waitcnt vmcnt(0)" ::: "memory")
#define WG_BAR() asm volatile("s_waitcnt vmcnt(0) lgkmcnt(0)\n\ts_barrier" ::: "memory")

typedef __bf16 bf16x2_t __attribute__((ext_vector_type(2)));
__device__ __forceinline__ unsigned cvtpk(float lo, float hi) { f32x2 v = {lo, hi}; bf16x2_t b = __builtin_convertvector(v, bf16x2_t); return __builtin_bit_cast(unsigned, b); }
__device__ __forceinline__ float bf2f(unsigned short b) { return __uint_as_float((unsigned)b << 16); }
__device__ __forceinline__ float bflo(unsigned w) { return __uint_as_float(w << 16); }
__device__ __forceinline__ float bfhi(unsigned w) { return __uint_as_float(w & 0xffff0000u); }
__device__ __forceinline__ float wave_sum(float v) {
#pragma unroll
    for (int o = 1; o < 64; o <<= 1) v += __shfl_xor(v, o);
    return v;
}
__device__ __forceinline__ float fast_exp2(float x) { return __builtin_amdgcn_exp2f(x); }
__device__ __forceinline__ float fast_rcp(float x) { return __builtin_amdgcn_rcpf(x); }
__device__ __forceinline__ float silu_f(float x) { return x * fast_rcp(1.0f + fast_exp2(-x * LOG2E)); }
__device__ __forceinline__ int crow(int r, int hi) { return (r & 3) + 8 * (r >> 2) + 4 * hi; }
__device__ __forceinline__ void glds16(const void* gsrc, unsigned lds_dst) { unsigned keep;
    asm volatile("s_mov_b32 %0, m0\n\ts_mov_b32 m0, %2\n\ts_nop 0\n\tglobal_load_lds_dwordx4 %1, off\n\ts_mov_b32 m0, %0" : "=&s"(keep) : "v"(gsrc), "s"(lds_dst) : "memory"); }
typedef short v4i16_t __attribute__((ext_vector_type(4)));
__device__ __forceinline__ s16x4 vtr(const LAS unsigned char* p) { return __builtin_bit_cast(s16x4, __builtin_amdgcn_ds_read_tr16_b64_v4i16((LAS v4i16_t*)p)); }
__device__ __forceinline__ bf16x8 cat8(s16x4 lo, s16x4 hi) { return (bf16x8){lo[0], lo[1], lo[2], lo[3], hi[0], hi[1], hi[2], hi[3]}; }
#define MFMA32(a, b, c) __builtin_amdgcn_mfma_f32_32x32x16_bf16(a, b, c, 0, 0, 0)

namespace pg8 {
#define PG8_LAS __attribute__((address_space(3)))
typedef unsigned short bf16_t;
typedef short bf16x8 __attribute__((ext_vector_type(8)));
typedef float f32x4 __attribute__((ext_vector_type(4)));
typedef unsigned u32x4 __attribute__((ext_vector_type(4)));
constexpr int BM = 256, BK = 64, HALF = 128, HTB = HALF * BK * 2  , STAGE_BYTES = 8 * HTB, NXCD = 8, WGM = 8;

__host__ __device__ __forceinline__ int lds_byte(int r, int c) { const int st = (r >> 4) * 2 + (c >> 5), rr = r & 15, cc = c & 31, ob = rr * 64 + cc * 2; return st * 1024 + (ob ^ (((ob >> 9) & 1) << 5)); }
__host__ __device__ __forceinline__ void stage_rc(int b, int& R, int& C) { const int st = b / 1024, sb = b % 1024, swz = sb ^ (((sb >> 9) & 1) << 5); R = (st >> 1) * 16 + swz / 64; C = (st & 1) * 32 + (swz % 64) / 2; }
__host__ __device__ __forceinline__ int perm32(int rho) { const int n = rho >> 4, i = rho & 15; return 8 * (i >> 2) + 4 * n + (i & 3); }

struct Unit { int pm, pn, aux; };

struct StaticOrder {
    int nM, nN, nwg, G, c;
    __host__ __device__ void init(int M, int N, int G_, int c_) { nM = M / BM; nN = N / BM; nwg = nM * nN; G = G_; c = c_; }
    __host__ __device__ bool next(int i, Unit& u) const {
        const long L = (long)i * G + c; if (L >= nwg) return false;
        int wgid = (int)L; { const int q = nwg / NXCD, r = nwg % NXCD, xcd = wgid % NXCD, off = wgid / NXCD; wgid = (xcd < r ? xcd * (q + 1) : r * (q + 1) + (xcd - r) * q) + off; }
        const int nig = WGM * nN, gid = wgid / nig, fm = gid * WGM, gsz = (nM - fm) < WGM ? (nM - fm) : WGM;
        u.pm = fm + ((wgid % nig) % gsz); u.pn = (wgid % nig) / gsz; return true;
    }
    __device__ __forceinline__ void a_ready(const Unit&) const {}
    __device__ __forceinline__ void done(const Unit&) const {}
};

template <class Epi, class Sched, bool ALIGN_EPI = false, bool SP2 = false>
__device__ __forceinline__ void gemm_phase(PG8_LAS unsigned char* lds, const int K, const Sched& S, const Epi& E) {
    const int tid = threadIdx.x, wid = __builtin_amdgcn_readfirstlane(tid >> 6), lane = tid & 63, wr = wid >> 2, wc = wid & 3, fr = lane & 15, fq = lane >> 4;
    const int nt = K / BK;
    unsigned voffA[2], voffB[2];
#pragma unroll
    for (int i = 0; i < 2; ++i) { int R, C; stage_rc(tid * 16 + i * 8192, R, C); const int Rb = Epi::PERM ? ((R & ~31) + perm32(R & 31)) : R;
        voffA[i] = (unsigned)(R * K + C) * 2u; voffB[i] = (unsigned)(Rb * K + C) * 2u; }
    const size_t kstep = (size_t)(BK * 2);
    const size_t hstep = (size_t)HALF * K * 2;
    const size_t tstep = 2 * hstep;
    const unsigned ldsw = (unsigned)wid * 1024u;
    const int aoff = lds_byte(wr * 64 + fr, fq * 8), boff = lds_byte(wc * 32 + fr, fq * 8);
#define PG8_SA(b, h) (((b) * 2 + (h)) * HTB)
#define PG8_SB(b, h) ((4 + (b) * 2 + (h)) * HTB)
#define PG8_STAGE(bufoff, gbase, voff) do { _Pragma("unroll") for (int _i = 0; _i < 2; ++_i) \
        __builtin_amdgcn_global_load_lds((const unsigned*)((const char*)(gbase) + (voff)[_i]), (PG8_LAS unsigned*)(lds + (bufoff) + ldsw + _i * 8192), 16, 0, 0); } while (0)
#define PG8_LDA(dst, b, h) do { _Pragma("unroll") for (int m = 0; m < 4; ++m) _Pragma("unroll") for (int k = 0; k < 2; ++k) dst[m][k] = *(const PG8_LAS bf16x8*)(lds + PG8_SA(b, h) + aoff + m * 2048 + k * 1024); } while (0)
#define PG8_LDB(dst, b, h) do { _Pragma("unroll") for (int n = 0; n < 2; ++n) _Pragma("unroll") for (int k = 0; k < 2; ++k) dst[n][k] = *(const PG8_LAS bf16x8*)(lds + PG8_SB(b, h) + boff + n * 2048 + k * 1024); } while (0)
#define PG8_MMA(ai, bj, At, Bt) do { __builtin_amdgcn_s_setprio(1); _Pragma("unroll") for (int m = 0; m < 4; ++m) _Pragma("unroll") for (int n = 0; n < 2; ++n) _Pragma("unroll") for (int k = 0; k < 2; ++k) \
        acc[ai][bj][m][n] = __builtin_amdgcn_mfma_f32_16x16x32_bf16(Bt[n][k], At[m][k], acc[ai][bj][m][n], 0, 0, 0); __builtin_amdgcn_s_setprio(0); } while (0)
#define PG8_WAIT_V(n) asm volatile("s_waitcnt vmcnt(" #n ")" ::: "memory")
#define PG8_WAIT_L(n) asm volatile("s_waitcnt lgkmcnt(" #n ")" ::: "memory")
#define PG8_BAR __builtin_amdgcn_s_barrier()
#define PG8_SCHED __builtin_amdgcn_sched_barrier(0)
    Unit cur, nxt; int ui = 0;
    if (!S.next(0, cur)) return;
    f32x4 acc[2][2][4][2];
#pragma unroll
    for (int a = 0; a < 2; ++a)
#pragma unroll
        for (int b = 0; b < 2; ++b)
#pragma unroll
            for (int m = 0; m < 4; ++m)
#pragma unroll
                for (int n = 0; n < 2; ++n) acc[a][b][m][n] = (f32x4){0.f, 0.f, 0.f, 0.f};
    bf16x8 At[4][2], B0[2][2], B1[2][2];
    const char* cA = S.aptr(cur); const char* cB = S.bptr(cur);
    S.a_ready(cur);
    if constexpr (SP2) {
        PG8_STAGE(PG8_SB(0, 0), cB, voffB); PG8_STAGE(PG8_SB(0, 1), cB + hstep, voffB); PG8_STAGE(PG8_SA(0, 0), cA, voffA); PG8_STAGE(PG8_SA(0, 1), cA + hstep, voffA);
        if (wr == 1) PG8_BAR;
        PG8_WAIT_V(2); PG8_BAR;
        PG8_STAGE(PG8_SB(1, 0), cB + kstep, voffB); PG8_STAGE(PG8_SA(1, 0), cA + kstep, voffA); PG8_STAGE(PG8_SB(1, 1), cB + hstep + kstep, voffB);
        PG8_WAIT_V(6); PG8_BAR;
    } else {
        PG8_STAGE(PG8_SB(0, 0), cB, voffB); PG8_STAGE(PG8_SA(0, 0), cA, voffA); PG8_STAGE(PG8_SB(0, 1), cB + hstep, voffB); PG8_STAGE(PG8_SA(0, 1), cA + hstep, voffA);
        if (wr == 1) PG8_BAR;
        PG8_WAIT_V(4); PG8_BAR;
        PG8_STAGE(PG8_SB(1, 0), cB + kstep, voffB); PG8_STAGE(PG8_SA(1, 0), cA + kstep, voffA); PG8_STAGE(PG8_SB(1, 1), cB + hstep + kstep, voffB);
        PG8_WAIT_V(6); PG8_BAR;
    }
    for (;;) {
        const bool has_next = S.next(ui + 1, nxt);
        const char* nA = has_next ? S.aptr(nxt) : cA; const char* nB = has_next ? S.bptr(nxt) : cB;
        for (int t = 0; t < nt; t += 2) {
            const bool last = (t == nt - 2);
            const char* a1 = cA + (size_t)(t + 1) * kstep;
            const char* a2 = last ? nA : cA + (size_t)(t + 2) * kstep; const char* b2 = last ? nB : cB + (size_t)(t + 2) * kstep;
            const char* a3 = a2 + kstep; const char* b3 = b2 + kstep;
            if (last && has_next) S.a_ready(nxt);
            if constexpr (SP2) {
            PG8_LDB(B0, 0, 0); PG8_LDB(B1, 0, 1); PG8_SCHED; PG8_LDA(At, 0, 0); PG8_STAGE(PG8_SA(1, 1), a1 + hstep, voffA);
            PG8_WAIT_V(8); PG8_WAIT_L(0); PG8_BAR; PG8_MMA(0, 0, At, B0); PG8_MMA(0, 1, At, B1); PG8_BAR; PG8_SCHED;
            PG8_LDA(At, 0, 1); PG8_STAGE(PG8_SB(0, 0), b2, voffB); PG8_STAGE(PG8_SB(0, 1), b2 + hstep, voffB); PG8_STAGE(PG8_SA(0, 0), a2, voffA);
            PG8_WAIT_V(8); PG8_WAIT_L(0); PG8_BAR; PG8_MMA(1, 0, At, B0); PG8_MMA(1, 1, At, B1); PG8_BAR; PG8_SCHED;
            PG8_LDB(B0, 1, 0); PG8_LDB(B1, 1, 1); PG8_SCHED; PG8_LDA(At, 1, 0); PG8_STAGE(PG8_SA(0, 1), a2 + hstep, voffA);
            PG8_WAIT_V(8); PG8_WAIT_L(0); PG8_BAR; PG8_MMA(0, 0, At, B0); PG8_MMA(0, 1, At, B1); PG8_BAR; PG8_SCHED;
            PG8_LDA(At, 1, 1); PG8_STAGE(PG8_SB(1, 0), b3, voffB); PG8_STAGE(PG8_SB(1, 1), b3 + hstep, voffB); PG8_STAGE(PG8_SA(1, 0), a3, voffA);
            PG8_WAIT_V(8); PG8_WAIT_L(0); PG8_BAR; PG8_MMA(1, 0, At, B0); PG8_MMA(1, 1, At, B1); PG8_BAR; PG8_SCHED;
            } else {
            PG8_LDB(B0, 0, 0); PG8_SCHED; PG8_LDA(At, 0, 0); PG8_STAGE(PG8_SA(1, 1), a1 + hstep, voffA);
            PG8_WAIT_L(8); PG8_BAR; PG8_WAIT_L(0); PG8_MMA(0, 0, At, B0); PG8_BAR; PG8_SCHED;
            PG8_LDB(B1, 0, 1); PG8_STAGE(PG8_SB(0, 0), b2, voffB);
            PG8_BAR; PG8_WAIT_L(0); PG8_MMA(0, 1, At, B1); PG8_BAR;
            PG8_LDA(At, 0, 1); PG8_STAGE(PG8_SA(0, 0), a2, voffA);
            PG8_BAR; PG8_WAIT_L(0); PG8_MMA(1, 0, At, B0); PG8_BAR; PG8_SCHED;
            PG8_STAGE(PG8_SB(0, 1), b2 + hstep, voffB);
            PG8_WAIT_V(6); PG8_BAR; PG8_MMA(1, 1, At, B1); PG8_BAR;
            PG8_LDB(B0, 1, 0); PG8_SCHED; PG8_LDA(At, 1, 0); PG8_STAGE(PG8_SA(0, 1), a2 + hstep, voffA);
            PG8_WAIT_L(8); PG8_BAR; PG8_WAIT_L(0); PG8_MMA(0, 0, At, B0); PG8_BAR; PG8_SCHED;
            PG8_LDB(B1, 1, 1); PG8_STAGE(PG8_SB(1, 0), b3, voffB);
            PG8_BAR; PG8_WAIT_L(0); PG8_MMA(0, 1, At, B1); PG8_BAR;
            PG8_LDA(At, 1, 1); PG8_STAGE(PG8_SA(1, 0), a3, voffA);
            PG8_BAR; PG8_WAIT_L(0); PG8_MMA(1, 0, At, B0); PG8_BAR; PG8_SCHED;
            PG8_STAGE(PG8_SB(1, 1), b3 + hstep, voffB);
            PG8_WAIT_V(6); PG8_BAR; PG8_MMA(1, 1, At, B1); PG8_BAR;
            }
        }
        if constexpr (ALIGN_EPI) { if (wr == 0) PG8_BAR; }
        if constexpr (!Epi::AFTER_DRAIN) { E(acc, cur, wr, wc, fr, fq); S.done(cur); }
        if (!has_next) break;
#pragma unroll
        for (int a = 0; a < 2; ++a)
#pragma unroll
            for (int b = 0; b < 2; ++b)
#pragma unroll
                for (int m = 0; m < 4; ++m)
#pragma unroll
                    for (int n = 0; n < 2; ++n) acc[a][b][m][n] = (f32x4){0.f, 0.f, 0.f, 0.f};
        cur = nxt; cA = nA; cB = nB; ++ui;
        if constexpr (ALIGN_EPI) { if (wr == 1) PG8_BAR; }
    }
    PG8_WAIT_V(0);
    if constexpr (!ALIGN_EPI) { if (wr == 0) PG8_BAR; }
    PG8_BAR;
    if constexpr (Epi::AFTER_DRAIN) { E.fused(acc, cur, wr, wc, fr, fq, lds, wid, lane); S.done(cur); }
#undef PG8_SA
#undef PG8_SB
#undef PG8_STAGE
#undef PG8_LDA
#undef PG8_LDB
#undef PG8_MMA
#undef PG8_WAIT_V
#undef PG8_WAIT_L
#undef PG8_BAR
#undef PG8_SCHED
}
}
#define XB_TMO      128
#define XB_XCNT(j)  (256  + 64 * (j))
#define XB_XSUB(j)  (1280 + 64 * (j))
#define XB_XGEN(j)  (2304 + 64 * (j))
#define XB_TOP      3328
#define XB_TOPGEN   3392
#define XCD_BAR_WORDS 3456
#define XB_SPIN_CAP (1u << 18)

__device__ __forceinline__ unsigned xb_ld(unsigned* p)              { return __hip_atomic_load(p, __ATOMIC_RELAXED, __HIP_MEMORY_SCOPE_AGENT); }
__device__ __forceinline__ unsigned xb_add(unsigned* p, unsigned v) { return __hip_atomic_fetch_add(p, v, __ATOMIC_RELAXED, __HIP_MEMORY_SCOPE_AGENT); }
__device__ __forceinline__ unsigned xb_xcc_id() { return (unsigned)__builtin_amdgcn_s_getreg((3 << 11) | 20) & 0xFu; }
#define XB_SPIN(cond, bar) do { unsigned _sp = 0; while (cond) { __builtin_amdgcn_s_sleep(1); \
    if ((++_sp & 255u) == 0u) { if (xb_ld(&(bar)[XB_TMO])) break; if (_sp > XB_SPIN_CAP) { atomicAdd(&(bar)[XB_TMO], 1u); break; } } } } while (0)

struct XcdBarrier {
    unsigned* bar; unsigned x;
    volatile LAS unsigned* st;
};

__device__ __forceinline__ XcdBarrier xcd_barrier_post(unsigned* bar, volatile LAS unsigned* st) {
    XcdBarrier b; b.bar = bar; b.x = xb_xcc_id(); b.st = st;
    if (threadIdx.x == 0) (void)xb_add(&bar[XB_XCNT(b.x)], 1u);
    return b;
}
__device__ __forceinline__ void xcd_barrier_complete(unsigned* bar, unsigned x, unsigned& nloc, unsigned& nx) {
    const unsigned G = gridDim.x * gridDim.y * gridDim.z;
    unsigned sum, cnt, mine, sp = 0u;
    for (;;) {
        sum = 0u; cnt = 0u; mine = 0u;
#pragma unroll
        for (unsigned j = 0; j < 16; ++j) { const unsigned c = xb_ld(&bar[XB_XCNT(j)]); sum += c; cnt += (c > 0u) ? 1u : 0u; mine = (j == x) ? c : mine; }
        if (sum == G) break;
        __builtin_amdgcn_s_sleep(1);
        if ((++sp & 255u) == 0u) { if (xb_ld(&bar[XB_TMO])) break; if (sp > XB_SPIN_CAP) { atomicAdd(&bar[XB_TMO], 1u); break; } }
    }
    nloc = mine > 0u ? mine : 1u; nx = cnt > 0u ? cnt : 1u;
}

__device__ __forceinline__ void xcd_barrier(const XcdBarrier& b) {
    asm volatile("s_waitcnt vmcnt(0)" ::: "memory");
    __syncthreads();
    if (threadIdx.x == 0) {
        unsigned* bar = b.bar;
        __builtin_amdgcn_s_waitcnt(0);
        unsigned nloc = b.st[0], nx = b.st[1];
        if (nloc == 0u) { xcd_barrier_complete(bar, b.x, nloc, nx); b.st[0] = nloc; b.st[1] = nx; }
        const unsigned old = xb_add(&bar[XB_XSUB(b.x)], 1u);
        const unsigned gen = old / nloc;
        if (old + 1u == (gen + 1u) * nloc) {
            __builtin_amdgcn_fence(__ATOMIC_RELEASE, "agent");
            asm volatile("s_waitcnt vmcnt(0)" ::: "memory");
            const unsigned og = xb_add(&bar[XB_TOP], 1u);
            const unsigned tg = og / nx;
            if (og + 1u == (tg + 1u) * nx) xb_add(&bar[XB_TOPGEN], 1u);
            else XB_SPIN(xb_ld(&bar[XB_TOPGEN]) == tg, bar);
            __builtin_amdgcn_fence(__ATOMIC_ACQUIRE, "agent");
            xb_add(&bar[XB_XGEN(b.x)], 1u);
            asm volatile("s_waitcnt vmcnt(0)" ::: "memory");
        } else {
            XB_SPIN(xb_ld(&bar[XB_XGEN(b.x)]) == gen, bar);
            __builtin_amdgcn_fence(__ATOMIC_ACQUIRE, "agent");
            asm volatile("s_waitcnt vmcnt(0)" ::: "memory");
        }
    }
    __syncthreads();
}

struct Frame {
    LAS unsigned char* lds;
    gu32* ctl;
    unsigned char* ws;
    int tid, lane, wave, vcu, G;
    const float* const* in;
    float* out;
};
enum { I_X = 0, I_MEM, I_LN1G, I_LN2G, I_MEMNG, I_WOUT, I_WKV, I_MQNG, I_MKNG, I_DAWIN, I_DAQNG, I_DAKNG, I_LQ1, I_LK1, I_LQ2, I_LK2, I_SUBG,
       I_SSMWIN, I_CONVW, I_CONVB, I_DTBIAS, I_ALOG, I_SSMD, I_SSMNG, I_FFNG, I_FFNU, I_FFND, I_ROUTER, I_MOEG, I_MOEU, I_MOED, N_IN };

__device__ __forceinline__ void cvt_item(const float* W, int ldw, int k0, int n0, int nvalid, bf16_t* WT, int K, int drow0, LAS float* scr, int lane) {
    const int c = lane & 31;
#pragma unroll 8
    for (int i = 0; i < 32; ++i) { const int kk = 2 * i + (lane >> 5); float v = 0.f; if (c < nvalid) v = W[(size_t)(k0 + kk) * ldw + n0 + c]; scr[kk * 33 + c] = v; }
    LDS_WAIT(); asm volatile("" ::: "memory");
    const int c8 = lane & 7;
#pragma unroll
    for (int j = 0; j < 4; ++j) { const int n = (lane >> 3) + 8 * j; const LAS float* s = scr + (8 * c8) * 33 + n;
        u32x4 o; o.x = cvtpk(s[0 * 33], s[1 * 33]); o.y = cvtpk(s[2 * 33], s[3 * 33]); o.z = cvtpk(s[4 * 33], s[5 * 33]); o.w = cvtpk(s[6 * 33], s[7 * 33]);
        *(GAS u32x4*)(WT + (size_t)(drow0 + n) * K + k0 + 8 * c8) = o; }
    LDS_WAIT(); asm volatile("" ::: "memory");
}
enum { CK_PLAIN = 0, CK_HPERM = 1, CK_SSM = 2, CK_GU = 3, CK_PLAIN_E = 4 };
template <int KIND>
__device__ __forceinline__ void cvt_job_item(const float* src0, const float* src1, int ldw, int K, int ngroups, int F, bf16_t* dst, int r, LAS float* scr, int lane) {
    const int kb = r / ngroups, gi = r - kb * ngroups, k0 = kb * 64;
    if (KIND == CK_PLAIN) { cvt_item(src0, ldw, k0, 32 * gi, 32, dst, K, 32 * gi, scr, lane); }
    else if (KIND == CK_HPERM) { const int pn = gi >> 3, gg = gi & 7, bj = gg >> 2, wc = gg & 3; cvt_item(src0, ldw, k0, 256 * pn + 64 * wc + 32 * bj, 32, dst, K, 32 * gi, scr, lane); }
    else if (KIND == CK_SSM) { const int pn = gi >> 3, gg = gi & 7, bj = gg >> 2, wc = gg & 3, s0 = 64 * wc + 32 * bj; int n0, nv;
        if (pn < 8) { n0 = 256 * pn + s0; nv = 32; } else if (pn == 8) { n0 = 2060 + s0; nv = 32; } else { n0 = 2048 + s0; nv = (s0 == 0) ? 12 : 0; if (nv == 0) n0 = 0; }
        cvt_item(src0, ldw, k0, n0, nv, dst, K, 32 * gi, scr, lane); }
    else if (KIND == CK_GU) { const int gpe = 2 * F / 32, e = gi / gpe, g2 = gi - e * gpe, j = g2 >> 3, gg = g2 & 7, bj = gg >> 2, wc = gg & 3;
        const float* s = (bj ? src1 : src0) + (size_t)e * K * F; cvt_item(s, F, k0, 128 * j + 32 * wc, 32, dst, K, e * 2 * F + 32 * g2, scr, lane); }
    else { const int gpe = F / 32, e = gi / gpe, g2 = gi - e * gpe;
        cvt_item(src0 + (size_t)e * K * F, F, k0, 32 * g2, 32, dst, K, e * F + 32 * g2, scr, lane); }
}

__device__ __forceinline__ void rms_row_bf16(const float* xrow, const float* g, bf16_t* orow, int lane) {
    const GAS f32x4* xr = (const GAS f32x4*)xrow + lane; const GAS f32x4* gr = (const GAS f32x4*)g + lane;
    f32x4 v[4]; float s = 0.f;
#pragma unroll
    for (int j = 0; j < 4; ++j) { v[j] = xr[64 * j]; s += (v[j].x * v[j].x + v[j].y * v[j].y) + (v[j].z * v[j].z + v[j].w * v[j].w); }
    const float rstd = 1.0f / sqrtf(wave_sum(s) * (1.f / DM) + EPS);
    GAS u32x2* o8 = (GAS u32x2*)orow + lane;
#pragma unroll
    for (int j = 0; j < 4; ++j) { const f32x4 gg = gr[64 * j]; u32x2 w; w.x = cvtpk(v[j].x * rstd * gg.x, v[j].y * rstd * gg.y); w.y = cvtpk(v[j].z * rstd * gg.z, v[j].w * rstd * gg.w); o8[64 * j] = w; }
}

__device__ __forceinline__ void phase_prologue(Frame& F) {
    LAS float* scr = (LAS float*)(F.lds + F.wave * 16384);
    const int gw = F.vcu * NWAVES + F.wave, NGW = F.G * NWAVES;
    const float* const* in = F.in;
    unsigned char* ws = F.ws;
    constexpr int J1 = 16 * 80, J2 = 16 * 32, J3 = 16 * 32, J4 = 16 * 16, J5 = 16 * 16, J6 = 16 * 80, J7 = 16 * 176, J8 = 44 * 32, J9 = 16 * 1792;
    constexpr int TOTAL = J1 + J2 + J3 + J4 + J5 + J6 + J7 + J8 + J9;
    for (int it = gw; it < TOTAL; it += NGW) {
        int r = it;
        if (r < J9) { cvt_job_item<CK_GU>(in[I_MOEG], in[I_MOEU], EXD, DM, 1792, EXD, (bf16_t*)(ws + WS_WMGU), r, scr, F.lane); continue; } r -= J9;
        if (r < J7) { cvt_job_item<CK_GU>(in[I_FFNG], in[I_FFNU], FFN, DM, 176, FFN, (bf16_t*)(ws + WS_WGU), r, scr, F.lane); continue; } r -= J7;
        if (r < J8) { cvt_job_item<CK_PLAIN>(in[I_FFND], nullptr, DM, FFN, 32, 0, (bf16_t*)(ws + WS_WDN), r, scr, F.lane); continue; } r -= J8;
        if (r < J1) { cvt_job_item<CK_HPERM>(in[I_DAWIN], nullptr, NPROJ, DM, 80, 0, (bf16_t*)(ws + WS_WDA), r, scr, F.lane); continue; } r -= J1;
        if (r < J6) { cvt_job_item<CK_SSM>(in[I_SSMWIN], nullptr, SSM_IN, DM, 80, 0, (bf16_t*)(ws + WS_WSSM), r, scr, F.lane); continue; } r -= J6;
        if (r < J2) { cvt_job_item<CK_PLAIN>(in[I_WOUT], nullptr, DM, DM, 32, 0, (bf16_t*)(ws + WS_WOUT0), r, scr, F.lane); continue; } r -= J2;
        if (r < J3) { cvt_job_item<CK_PLAIN>(in[I_WOUT] + (size_t)DM * DM, nullptr, DM, DM, 32, 0, (bf16_t*)(ws + WS_WOUT1), r, scr, F.lane); continue; } r -= J3;
        if (r < J4) { cvt_job_item<CK_HPERM>(in[I_WKV], nullptr, 512, DM, 16, 0, (bf16_t*)(ws + WS_WKV0), r, scr, F.lane); continue; } r -= J4;
        cvt_job_item<CK_HPERM>(in[I_WKV] + (size_t)DM * 512, nullptr, 512, DM, 16, 0, (bf16_t*)(ws + WS_WKV1), r, scr, F.lane);
    }
    for (int m = gw; m < MEMROWS; m += NGW) rms_row_bf16(in[I_MEM] + (size_t)m * DM, in[I_MEMNG], (bf16_t*)(ws + WS_MEMN) + (size_t)m * DM, F.lane);
    for (int m = gw; m < T; m += NGW) rms_row_bf16(in[I_X] + (size_t)m * DM, in[I_LN1G], (bf16_t*)(ws + WS_XN) + (size_t)m * DM, F.lane);
#if MK_LEVEL == 0
    for (int m = gw; m < T; m += NGW) { const GAS f32x4* xr = (const GAS f32x4*)(in[I_X] + (size_t)m * DM) + F.lane; GAS f32x4* o = (GAS f32x4*)(F.out + (size_t)m * DM) + F.lane;
#pragma unroll
        for (int j = 0; j < 4; ++j) o[64 * j] = xr[64 * j]; }
#endif
}
__device__ __forceinline__ void phase_cvt_moe_down(Frame& F) {
    LAS float* scr = (LAS float*)(F.lds + F.wave * 16384);
    const int gw = F.vcu * NWAVES + F.wave, NGW = F.G * NWAVES;
    constexpr int TOTAL = 56 * 256;
    for (int it = gw; it < TOTAL; it += NGW) cvt_job_item<CK_PLAIN_E>(F.in[I_MOED], nullptr, DM, EXD, 256, DM, (bf16_t*)(F.ws + WS_WMGU), it, scr, F.lane);
}
__device__ __forceinline__ void phase_rownorm(Frame& F, const float* g, bf16_t* dst) {
    const int gw = F.vcu * NWAVES + F.wave, NGW = F.G * NWAVES;
    for (int m = gw; m < T; m += NGW) rms_row_bf16(F.out + (size_t)m * DM, g, dst + (size_t)m * DM, F.lane);
}

struct SchedPlain : pg8::StaticOrder {
    const char* A; const char* B; size_t ta, tb;
    __device__ __forceinline__ const char* aptr(const pg8::Unit& u) const { return A + (size_t)u.pm * ta; }
    __device__ __forceinline__ const char* bptr(const pg8::Unit& u) const { return B + (size_t)u.pn * tb; }
};
struct SchedP1 {
    pg8::StaticOrder so; const char* ws;
    __device__ __forceinline__ bool next(int i, pg8::Unit& u) const {
        if (so.next(i, u)) { u.aux = 0; return true; }
        const long L = (long)i * so.G + so.c - so.nwg; if (L >= 16) return false;
        const int r = (int)L; u.aux = 1 + (r >> 3); u.pm = (r & 7) >> 1; u.pn = r & 1; return true;
    }
    __device__ __forceinline__ const char* aptr(const pg8::Unit& u) const { const size_t o = (u.aux == 0) ? WS_XN : WS_MEMN; return ws + o + (size_t)u.pm * (256 * DM * 2); }
    __device__ __forceinline__ const char* bptr(const pg8::Unit& u) const { const size_t o = (u.aux == 0) ? WS_WDA : (u.aux == 1 ? WS_WKV0 : WS_WKV1); return ws + o + (size_t)u.pn * (256 * DM * 2); }
    __device__ __forceinline__ void a_ready(const pg8::Unit&) const {}
    __device__ __forceinline__ void done(const pg8::Unit&) const {}
};
struct SchedMoe : pg8::StaticOrder {
    const char* A; const char* B; size_t ta, tb, eb; const int* tile_e;
    __device__ __forceinline__ bool next(int i, pg8::Unit& u) const { if (!pg8::StaticOrder::next(i, u)) return false; u.aux = tile_e[u.pm]; return true; }
    __device__ __forceinline__ const char* aptr(const pg8::Unit& u) const { return A + (size_t)u.pm * ta; }
    __device__ __forceinline__ const char* bptr(const pg8::Unit& u) const { return B + (size_t)u.aux * eb + (size_t)u.pn * tb; }
};

struct TileCfg { bf16_t* out; int ldc; int col0; int mode; int gain_off; float scale; float* dt; };
template <class CfgF> struct EpiProj {
    static constexpr bool PERM = true, AFTER_DRAIN = false;
    CfgF cf; LAS unsigned char* lds;
    __device__ __forceinline__ void operator()(const f32x4 (&acc)[2][2][4][2], const pg8::Unit& u, int wr, int wc, int fr, int fq) const {
        const TileCfg c = cf(u);
        const int row0 = u.pm * 256 + wr * 64 + fr;
        if (c.mode == 2) {
            if (wc == 0 && fq < 2) {
#pragma unroll
                for (int ai = 0; ai < 2; ++ai)
#pragma unroll
                    for (int m = 0; m < 4; ++m) { float* p = c.dt + (size_t)(row0 + ai * 128 + m * 16) * 16 + fq * 8; *(f32x4*)p = acc[ai][0][m][0]; *(f32x4*)(p + 4) = acc[ai][0][m][1]; }
            }
            return;
        }
        f32x4 gv[2][2];
#pragma unroll
        for (int bj = 0; bj < 2; ++bj)
#pragma unroll
            for (int n = 0; n < 2; ++n) gv[bj][n] = (c.mode == 1) ? *(const LAS f32x4*)(lds + c.gain_off + (32 * bj + 8 * fq + 4 * n) * 4) : (f32x4){1.f, 1.f, 1.f, 1.f};
#pragma unroll
        for (int ai = 0; ai < 2; ++ai)
#pragma unroll
            for (int m = 0; m < 4; ++m) {
                float rs = 1.0f;
                if (c.mode == 1) {
                    float ss = 0.f;
#pragma unroll
                    for (int bj = 0; bj < 2; ++bj)
#pragma unroll
                        for (int n = 0; n < 2; ++n) { const f32x4 v = acc[ai][bj][m][n]; ss += (v.x * v.x + v.y * v.y) + (v.z * v.z + v.w * v.w); }
                    ss += __shfl_xor(ss, 16); ss += __shfl_xor(ss, 32);
                    rs = c.scale / sqrtf(ss * (1.0f / 64.0f) + EPS);
                }
                bf16_t* rowp = c.out + (size_t)(row0 + ai * 128 + m * 16) * c.ldc + c.col0 + 64 * wc + 8 * fq;
#pragma unroll
                for (int bj = 0; bj < 2; ++bj) { const f32x4 v0 = acc[ai][bj][m][0] * gv[bj][0] * rs, v1 = acc[ai][bj][m][1] * gv[bj][1] * rs;
                    u32x4 w; w.x = cvtpk(v0.x, v0.y); w.y = cvtpk(v0.z, v0.w); w.z = cvtpk(v1.x, v1.y); w.w = cvtpk(v1.z, v1.w);
                    *(u32x4*)(rowp + 32 * bj) = w; }
            }
    }
};
struct EpiSwiGLU {
    static constexpr bool PERM = true, AFTER_DRAIN = false;
    bf16_t* O; int ldc;
    __device__ __forceinline__ void operator()(const f32x4 (&acc)[2][2][4][2], const pg8::Unit& u, int wr, int wc, int fr, int fq) const {
        const int row0 = u.pm * 256 + wr * 64 + fr, col0 = u.pn * 128 + wc * 32 + 8 * fq;
#pragma unroll
        for (int ai = 0; ai < 2; ++ai)
#pragma unroll
            for (int m = 0; m < 4; ++m) { const f32x4 g0 = acc[ai][0][m][0], g1 = acc[ai][0][m][1], u0 = acc[ai][1][m][0], u1 = acc[ai][1][m][1];
                u32x4 w; w.x = cvtpk(silu_f(g0.x) * u0.x, silu_f(g0.y) * u0.y); w.y = cvtpk(silu_f(g0.z) * u0.z, silu_f(g0.w) * u0.w);
                w.z = cvtpk(silu_f(g1.x) * u1.x, silu_f(g1.y) * u1.y); w.w = cvtpk(silu_f(g1.z) * u1.z, silu_f(g1.w) * u1.w);
                *(u32x4*)(O + (size_t)(row0 + ai * 128 + m * 16) * ldc + col0) = w; }
    }
};
struct EpiResid {
    static constexpr bool PERM = false, AFTER_DRAIN = false;
    const float* base; float* out;
    __device__ __forceinline__ void operator()(const f32x4 (&acc)[2][2][4][2], const pg8::Unit& u, int wr, int wc, int fr, int fq) const {
        const int row0 = u.pm * 256 + wr * 64 + fr, col0 = u.pn * 256 + wc * 32 + 4 * fq;
#pragma unroll
        for (int ai = 0; ai < 2; ++ai)
#pragma unroll
            for (int m = 0; m < 4; ++m) { const size_t off = (size_t)(row0 + ai * 128 + m * 16) * DM + col0;
#pragma unroll
                for (int bj = 0; bj < 2; ++bj)
#pragma unroll
                    for (int n = 0; n < 2; ++n) { const f32x4 b = *(const f32x4*)(base + off + bj * 128 + n * 16); *(f32x4*)(out + off + bj * 128 + n * 16) = b + acc[ai][bj][m][n]; } }
    }
};
struct EpiBf16 {
    static constexpr bool PERM = true, AFTER_DRAIN = false;
    bf16_t* O; int ldc;
    __device__ __forceinline__ void operator()(const f32x4 (&acc)[2][2][4][2], const pg8::Unit& u, int wr, int wc, int fr, int fq) const {
        const int row0 = u.pm * 256 + wr * 64 + fr, col0 = u.pn * 256 + wc * 32 + 8 * fq;
#pragma unroll
        for (int ai = 0; ai < 2; ++ai)
#pragma unroll
            for (int m = 0; m < 4; ++m) { bf16_t* rowp = O + (size_t)(row0 + ai * 128 + m * 16) * ldc + col0;
#pragma unroll
                for (int bj = 0; bj < 2; ++bj) { const f32x4 v0 = acc[ai][bj][m][0], v1 = acc[ai][bj][m][1];
                    u32x4 w; w.x = cvtpk(v0.x, v0.y); w.y = cvtpk(v0.z, v0.w); w.z = cvtpk(v1.x, v1.y); w.w = cvtpk(v1.z, v1.w);
                    *(u32x4*)(rowp + bj * 128) = w; } }
    }
};

constexpr int LC_QG = CONST_OFF + 0, LC_KG = CONST_OFF + 256, LC_MQG = CONST_OFF + 512, LC_MKG0 = CONST_OFF + 768, LC_MKG1 = CONST_OFF + 1024;
constexpr int LC_SCAL = CONST_OFF + 1280;
constexpr int LC_SUBG = CONST_OFF + 1536;
constexpr int LC_QIDX = MISC_OFF + 64;

struct CfgP1 { bf16_t* U; bf16_t* KVM;
    __device__ __forceinline__ TileCfg operator()(const pg8::Unit& u) const { TileCfg c; c.dt = nullptr;
        if (u.aux == 0) { c.out = U; c.ldc = NPROJ; c.col0 = 256 * u.pn;
            if (u.pn < 3) { c.mode = 1; c.gain_off = LC_QG; c.scale = 0.125f * LOG2E; }
            else if (u.pn < 6) { c.mode = 1; c.gain_off = LC_KG; c.scale = 1.0f; }
            else if (u.pn < 9) { c.mode = 0; c.gain_off = LC_QG; c.scale = 1.0f; }
            else { c.mode = 1; c.gain_off = LC_MQG; c.scale = 0.125f * LOG2E; } }
        else { c.out = KVM + (size_t)(u.aux - 1) * MEMROWS * 512; c.ldc = 512; c.col0 = 256 * u.pn; c.scale = 1.0f; c.gain_off = (u.aux == 1) ? LC_MKG0 : LC_MKG1; c.mode = (u.pn == 0) ? 1 : 0; }
        return c; } };
struct CfgP8 { bf16_t* U; float* DT;
    __device__ __forceinline__ TileCfg operator()(const pg8::Unit& u) const { TileCfg c; c.out = U; c.ldc = NPROJ; c.col0 = 256 * u.pn; c.dt = DT; c.gain_off = LC_MQG; c.scale = 1.0f; c.mode = 0;
        if (u.pn == 8) { c.mode = 1; c.scale = 0.125f * LOG2E; } else if (u.pn == 9) c.mode = 2;
        return c; } };

__device__ __forceinline__ void lds_load_vec64(Frame& F, int off, const float* src) { if (F.tid < 64) *(LAS float*)(F.lds + off + F.tid * 4) = src[F.tid]; }

constexpr int AT_K = 0, AT_V = 32768, AT_X = 65536;

__device__ __forceinline__ void diff_attn_unit(Frame& F, int b, int h, int j, const bf16_t* U, bf16_t* MIX) {
    LAS unsigned char* lds = F.lds;
    const int lane = F.lane, r32 = lane & 31, hi = lane >> 5, w = F.wave, map = w & 1, qsub = w >> 1;
    const size_t rowbase = (size_t)b * SEQ; const int q0 = j * 128;
    const float shift = *(const LAS float*)(lds + LC_SCAL), lam = *(const LAS float*)(lds + LC_SCAL + 4);
    const bf16_t* Qw = U + (rowbase + q0 + qsub * 32 + r32) * NPROJ + h * 128 + map * 64 + hi * 8;
    bf16x8 qr[4];
#pragma unroll
    for (int d0 = 0; d0 < 4; ++d0) qr[d0] = *(const bf16x8*)(Qw + d0 * 16);
    const int NT = 2 * j + 2, myNT = 2 * j + 1 + (qsub >> 1);
    const bf16_t* ksrc = U + (rowbase + lane) * NPROJ + 768 + h * 128 + w * 8;
    const bf16_t* vsrc = U + (rowbase + 16 * (w & 3) + (lane >> 2)) * NPROJ + 1536 + h * 128 + (w >> 2) * 32 + (lane & 3) * 8;
    const unsigned lds0 = (unsigned)(uintptr_t)lds;
#define AT_DMA(t, slot) do { const size_t o_ = (size_t)(t) * 64 * NPROJ; \
        glds16(ksrc + o_, (unsigned)__builtin_amdgcn_readfirstlane(lds0 + AT_K + (slot) * 16384 + w * 1024)); \
        glds16(ksrc + o_ + 64, (unsigned)__builtin_amdgcn_readfirstlane(lds0 + AT_K + (slot) * 16384 + 8192 + w * 1024)); \
        glds16(vsrc + o_, (unsigned)__builtin_amdgcn_readfirstlane(lds0 + AT_V + (slot) * 16384 + w * 1024)); \
        glds16(vsrc + o_ + 64, (unsigned)__builtin_amdgcn_readfirstlane(lds0 + AT_V + (slot) * 16384 + 8192 + w * 1024)); } while (0)
    AT_DMA(0, 0);
    f32x16 oT[4]; float lsum = 0.f;
#pragma unroll
    for (int i = 0; i < 4; ++i) oT[i] = (f32x16){};
    f32x16 negs;
#pragma unroll
    for (int r = 0; r < 16; ++r) negs[r] = -shift;
    for (int t = 0; t < NT; ++t) {
        WG_BAR();
        const int slot = t & 1;
        if (t + 1 < NT) AT_DMA(t + 1, slot ^ 1);
        if (t < myNT) {
            const LAS unsigned char* kb = lds + AT_K + slot * 16384 + map * 8192 + hi * 1024 + r32 * 16;
            f32x16 s0 = negs, s1 = negs;
#pragma unroll
            for (int d0 = 0; d0 < 4; ++d0) { const bf16x8 a0 = *(const LAS bf16x8*)(kb + d0 * 2048), a1 = *(const LAS bf16x8*)(kb + d0 * 2048 + 512);
                s0 = MFMA32(a0, qr[d0], s0); s1 = MFMA32(a1, qr[d0], s1); }
#pragma unroll
            for (int r = 0; r < 16; ++r) { s0[r] = fast_exp2(s0[r]); s1[r] = fast_exp2(s1[r]); }
            float ps = 0.f;
#pragma unroll
            for (int r = 0; r < 16; ++r) ps += s0[r] + s1[r];
            lsum += ps;
            u32x4 pw[4];
#pragma unroll
            for (int q = 0; q < 4; ++q) { pw[0][q] = cvtpk(s0[2 * q], s0[2 * q + 1]); pw[1][q] = cvtpk(s0[8 + 2 * q], s0[8 + 2 * q + 1]);
                                          pw[2][q] = cvtpk(s1[2 * q], s1[2 * q + 1]); pw[3][q] = cvtpk(s1[8 + 2 * q], s1[8 + 2 * q + 1]); }
            const LAS unsigned char* vp = lds + AT_V + slot * 16384 + ((lane >> 4) & 1) * 32 + (lane & 3) * 8 + (4 * hi + ((lane & 15) >> 2)) * 64;
#pragma unroll
            for (int db = 0; db < 4; ++db)
#pragma unroll
                for (int ks = 0; ks < 4; ++ks) { const s16x4 lo = vtr(vp + db * 4096 + ks * 1024), hh = vtr(vp + db * 4096 + ks * 1024 + 512);
                    oT[db] = MFMA32(cat8(lo, hh), __builtin_bit_cast(bf16x8, pw[ks]), oT[db]); }
        }
    }
#undef AT_DMA
    lsum += __shfl_xor(lsum, 32);
    const float inv = 1.0f / lsum;
    LAS float* xch = (LAS float*)(lds + AT_X + qsub * 16384);
    if (map == 1) {
        const float f = lam * inv;
#pragma unroll
        for (int db = 0; db < 4; ++db)
#pragma unroll
            for (int r = 0; r < 16; ++r) xch[(db * 16 + r) * 64 + lane] = oT[db][r] * f;
    }
    WG_BAR();
    if (map == 0) {
        float ss = 0.f;
#pragma unroll
        for (int db = 0; db < 4; ++db)
#pragma unroll
            for (int r = 0; r < 16; ++r) { const float o = oT[db][r] * inv - xch[(db * 16 + r) * 64 + lane]; oT[db][r] = o; ss += o * o; }
        ss += __shfl_xor(ss, 32);
        const float rs = 0.8f / sqrtf(ss * (1.0f / 128.0f) + EPS);
        bf16_t* orow = MIX + (rowbase + q0 + qsub * 32 + r32) * DM + h * 128;
        const LAS float* sg = (const LAS float*)(lds + LC_SUBG);
#pragma unroll
        for (int db = 0; db < 4; ++db)
#pragma unroll
            for (int q = 0; q < 4; ++q) { const int d = 32 * db + 8 * q + 4 * hi; const f32x4 g = *(const LAS f32x4*)(sg + d);
                u32x2 wv; wv.x = cvtpk(oT[db][4 * q] * rs * g.x, oT[db][4 * q + 1] * rs * g.y); wv.y = cvtpk(oT[db][4 * q + 2] * rs * g.z, oT[db][4 * q + 3] * rs * g.w);
                *(u32x2*)(orow + d) = wv; }
    }
}

__device__ __forceinline__ void mem_attn_unit(Frame& F, int b, int mh, int qb, const bf16_t* U, int mqcol, const bf16_t* KVM, bf16_t* MIX) {
    LAS unsigned char* lds = F.lds;
    const int lane = F.lane, r32 = lane & 31, hi = lane >> 5, w = F.wave;
    const float shift = *(const LAS float*)(lds + LC_SCAL + 8);
    const size_t row = (size_t)b * SEQ + qb * 256 + w * 32 + r32;
    const bf16_t* Qw = U + row * NPROJ + mqcol + mh * 64 + hi * 8;
    bf16x8 qr[4];
#pragma unroll
    for (int d0 = 0; d0 < 4; ++d0) qr[d0] = *(const bf16x8*)(Qw + d0 * 16);
    const unsigned lds0 = (unsigned)(uintptr_t)lds;
    const bf16_t* ksrc = KVM + ((size_t)b * MEM_LEN + lane) * 512 + mh * 64 + w * 8;
    const bf16_t* vsrc = KVM + ((size_t)b * MEM_LEN + 16 * (w & 3) + (lane >> 2)) * 512 + 256 + mh * 64 + (w >> 2) * 32 + (lane & 3) * 8;
#pragma unroll
    for (int t = 0; t < 4; ++t) { glds16(ksrc + (size_t)t * 64 * 512, (unsigned)__builtin_amdgcn_readfirstlane(lds0 + t * 8192 + w * 1024));
                                  glds16(vsrc + (size_t)t * 64 * 512, (unsigned)__builtin_amdgcn_readfirstlane(lds0 + 32768 + t * 8192 + w * 1024)); }
    WG_BAR();
    f32x16 oT[2]; oT[0] = (f32x16){}; oT[1] = (f32x16){}; float lsum = 0.f;
    f32x16 negs;
#pragma unroll
    for (int r = 0; r < 16; ++r) negs[r] = -shift;
#pragma unroll 1
    for (int t = 0; t < 4; ++t) {
        const LAS unsigned char* kb = lds + t * 8192 + hi * 1024 + r32 * 16;
        f32x16 s0 = negs, s1 = negs;
#pragma unroll
        for (int d0 = 0; d0 < 4; ++d0) { const bf16x8 a0 = *(const LAS bf16x8*)(kb + d0 * 2048), a1 = *(const LAS bf16x8*)(kb + d0 * 2048 + 512);
            s0 = MFMA32(a0, qr[d0], s0); s1 = MFMA32(a1, qr[d0], s1); }
        float ps = 0.f;
#pragma unroll
        for (int r = 0; r < 16; ++r) { s0[r] = fast_exp2(s0[r]); s1[r] = fast_exp2(s1[r]); ps += s0[r] + s1[r]; }
        lsum += ps;
        u32x4 pw[4];
#pragma unroll
        for (int q = 0; q < 4; ++q) { pw[0][q] = cvtpk(s0[2 * q], s0[2 * q + 1]); pw[1][q] = cvtpk(s0[8 + 2 * q], s0[8 + 2 * q + 1]);
                                      pw[2][q] = cvtpk(s1[2 * q], s1[2 * q + 1]); pw[3][q] = cvtpk(s1[8 + 2 * q], s1[8 + 2 * q + 1]); }
        const LAS unsigned char* vp = lds + 32768 + t * 8192 + ((lane >> 4) & 1) * 32 + (lane & 3) * 8 + (4 * hi + ((lane & 15) >> 2)) * 64;
#pragma unroll
        for (int db = 0; db < 2; ++db)
#pragma unroll
            for (int ks = 0; ks < 4; ++ks) { const s16x4 lo = vtr(vp + db * 4096 + ks * 1024), hh = vtr(vp + db * 4096 + ks * 1024 + 512);
                oT[db] = MFMA32(cat8(lo, hh), __builtin_bit_cast(bf16x8, pw[ks]), oT[db]); }
    }
    lsum += __shfl_xor(lsum, 32);
    const float inv = 1.0f / lsum;
    bf16_t* orow = MIX + row * DM + TOK_W + mh * 64;
#pragma unroll
    for (int db = 0; db < 2; ++db)
#pragma unroll
        for (int q = 0; q < 4; ++q) { const int d = 32 * db + 8 * q + 4 * hi;
            u32x2 wv; wv.x = cvtpk(oT[db][4 * q] * inv, oT[db][4 * q + 1] * inv); wv.y = cvtpk(oT[db][4 * q + 2] * inv, oT[db][4 * q + 3] * inv);
            *(u32x2*)(orow + d) = wv; }
    WG_BAR();
}

__device__ __forceinline__ int queue_pop(Frame& F, gu32* head) {
    if (F.tid == 0) *(volatile LAS unsigned*)(F.lds + LC_QIDX) = __hip_atomic_fetch_add(head, 1u, RLX_AGENT);
    WG_BAR();
    const int v = (int)*(volatile LAS unsigned*)(F.lds + LC_QIDX);
    WG_BAR();
    return v;
}
__device__ __forceinline__ float max_abs64(const float* g, int lane) { float v = fabsf(g[lane]);
#pragma unroll
    for (int o = 1; o < 64; o <<= 1) v = fmaxf(v, __shfl_xor(v, o));
    return v; }
__device__ __forceinline__ void attn_consts(Frame& F, int layer) {
    const float* const* in = F.in;
    if (F.wave == 0) {
        const int l = F.lane;
        const float mq = max_abs64(in[I_DAQNG], l), mk = max_abs64(in[I_DAKNG], l);
        const float a = wave_sum(in[I_LQ1][l] * in[I_LK1][l]), c = wave_sum(in[I_LQ2][l] * in[I_LK2][l]);
        const float mmq = max_abs64(in[I_MQNG] + layer * 64, l), mmk = max_abs64(in[I_MKNG] + layer * 64, l);
        if (l == 0) { LAS float* s = (LAS float*)(F.lds + LC_SCAL); s[0] = 8.0f * mq * mk * LOG2E; s[1] = expf(a) - expf(c) + 0.2f; s[2] = 8.0f * mmq * mmk * LOG2E; }
        ((LAS float*)(F.lds + LC_SUBG))[l] = in[I_SUBG][l]; ((LAS float*)(F.lds + LC_SUBG))[64 + l] = in[I_SUBG][64 + l];
    }
    WG_BAR();
}
__device__ __forceinline__ void phase_attn0(Frame& F) {
    attn_consts(F, 0);
    const bf16_t* U = (const bf16_t*)(F.ws + WS_U); bf16_t* MIX = (bf16_t*)(F.ws + WS_MIX); const bf16_t* KVM = (const bf16_t*)(F.ws + WS_KVM);
    for (;;) {
        const int u = queue_pop(F, F.ctl + CW_Q0);
        if (u >= 768 + 256) break;
        if (u < 768) { const int j = 31 - u / 24, bh = u % 24; diff_attn_unit(F, bh / 6, bh % 6, j, U, MIX); }
        else { const int v = u - 768; mem_attn_unit(F, v >> 6, (v >> 4) & 3, v & 15, U, 2304, KVM, MIX); }
    }
}
__device__ __forceinline__ void phase_memattn1(Frame& F) {
    attn_consts(F, 1);
    const bf16_t* U = (const bf16_t*)(F.ws + WS_U); bf16_t* MIX = (bf16_t*)(F.ws + WS_MIX); const bf16_t* KVM = (const bf16_t*)(F.ws + WS_KVM) + (size_t)MEMROWS * 512;
    for (;;) {
        const int v = queue_pop(F, F.ctl + CW_Q1);
        if (v >= 256) break;
        mem_attn_unit(F, v >> 6, (v >> 4) & 3, v & 15, U, 2048, KVM, MIX);
    }
}

constexpr int LC_CUM = CONST_OFF + 2048, LC_DTS = CONST_OFF + 3584, LC_PART = CONST_OFF + 5120, LC_NG = CONST_OFF + 6144;
constexpr int S1_XS = 0, S1_BM = 49152, S1_TOEND = 65536;
__device__ __forceinline__ float softplus_f(float x) { return x > 20.0f ? x : log1pf(expf(x)); }

__device__ __forceinline__ void phase_ssd_local(Frame& F) {
    LAS unsigned char* lds = F.lds; const float* const* in = F.in;
    const bf16_t* U = (const bf16_t*)(F.ws + WS_U); bf16_t* CONV = (bf16_t*)(F.ws + WS_CONV); bf16_t* ST = (bf16_t*)(F.ws + WS_STATES);
    const float* DT = (const float*)(F.ws + WS_DT); float* DTC = (float*)(F.ws + WS_DTC); float* CD = (float*)(F.ws + WS_CD);
    const int lane = F.lane, w = F.wave, tid = F.tid, r32 = lane & 31, hi = lane >> 5;
    for (int unit = F.vcu; unit < BATCH * NCH * 2; unit += F.G) {
        const int g = unit & 1, c = (unit >> 1) & 63, b = unit >> 7;
        const size_t r0 = (size_t)b * SEQ + c * 64;
        if (w < 6) {
            const int h = g * 6 + w; const size_t row = r0 + lane;
            const float dt = softplus_f(DT[row * 16 + h] + in[I_DTBIAS][h]);
            const float a = -expf(in[I_ALOG][h]);
            float cum = dt * a;
#pragma unroll
            for (int o = 1; o < 64; o <<= 1) { const float v = __shfl_up(cum, o); if (lane >= o) cum += v; }
            const float total = __shfl(cum, 63);
            ((LAS float*)(lds + S1_TOEND))[w * 64 + lane] = expf(total - cum) * dt;
            DTC[row * 24 + h * 2] = dt; DTC[row * 24 + h * 2 + 1] = cum;
            if (lane == 63) CD[((size_t)b * NCH + c) * 12 + h] = expf(total);
        }
        WG_BAR();
        if (tid < 320) {
            const int cg = tid % 80, tseg = tid / 80;
            int ch; if (cg < 48) ch = g * 384 + 8 * cg; else if (cg < 64) ch = 768 + g * 128 + 8 * (cg - 48); else ch = 1024 + g * 128 + 8 * (cg - 64);
            float wk[4][8], bias[8];
#pragma unroll
            for (int k = 0; k < 4; ++k) { const f32x4 a0 = *(const f32x4*)(in[I_CONVW] + k * SSM_CONV + ch), a1 = *(const f32x4*)(in[I_CONVW] + k * SSM_CONV + ch + 4);
                wk[k][0] = a0.x; wk[k][1] = a0.y; wk[k][2] = a0.z; wk[k][3] = a0.w; wk[k][4] = a1.x; wk[k][5] = a1.y; wk[k][6] = a1.z; wk[k][7] = a1.w; }
            { const f32x4 a0 = *(const f32x4*)(in[I_CONVB] + ch), a1 = *(const f32x4*)(in[I_CONVB] + ch + 4);
              bias[0] = a0.x; bias[1] = a0.y; bias[2] = a0.z; bias[3] = a0.w; bias[4] = a1.x; bias[5] = a1.y; bias[6] = a1.z; bias[7] = a1.w; }
            const int t0 = tseg * 16; const int pos0 = c * 64 + t0;
            const bf16_t* src = U + (r0 + t0) * NPROJ + 768 + ch;
            u32x4 win[3];
#pragma unroll
            for (int k = 0; k < 3; ++k) win[k] = (pos0 - 3 + k >= 0) ? *(const u32x4*)(src + (ptrdiff_t)(k - 3) * NPROJ) : (u32x4){0u, 0u, 0u, 0u};
#pragma unroll 4
            for (int tt = 0; tt < 16; ++tt) {
                const u32x4 cur = *(const u32x4*)(src + (size_t)tt * NPROJ);
                float o[8];
#pragma unroll
                for (int q = 0; q < 4; ++q) {
                    o[2 * q] = bias[2 * q] + wk[0][2 * q] * bflo(win[0][q]) + wk[1][2 * q] * bflo(win[1][q]) + wk[2][2 * q] * bflo(win[2][q]) + wk[3][2 * q] * bflo(cur[q]);
                    o[2 * q + 1] = bias[2 * q + 1] + wk[0][2 * q + 1] * bfhi(win[0][q]) + wk[1][2 * q + 1] * bfhi(win[1][q]) + wk[2][2 * q + 1] * bfhi(win[2][q]) + wk[3][2 * q + 1] * bfhi(cur[q]);
                }
#pragma unroll
                for (int q = 0; q < 8; ++q) o[q] = silu_f(o[q]);
                const int t = t0 + tt;
                u32x4 pk; pk.x = cvtpk(o[0], o[1]); pk.y = cvtpk(o[2], o[3]); pk.z = cvtpk(o[4], o[5]); pk.w = cvtpk(o[6], o[7]);
                *(u32x4*)(CONV + (r0 + t) * SSM_CONV + ch) = pk;
                if (cg < 48) { const float sc = ((const LAS float*)(lds + S1_TOEND))[(cg >> 3) * 64 + t]; const int lc = 8 * cg;
                    u32x4 ps; ps.x = cvtpk(o[0] * sc, o[1] * sc); ps.y = cvtpk(o[2] * sc, o[3] * sc); ps.z = cvtpk(o[4] * sc, o[5] * sc); ps.w = cvtpk(o[6] * sc, o[7] * sc);
                    *(LAS u32x4*)(lds + S1_XS + (lc >> 5) * 4096 + t * 64 + ((lc & 31) >> 3) * 16) = ps; }
                else if (cg < 64) { const int lc = 8 * (cg - 48); *(LAS u32x4*)(lds + S1_BM + (lc >> 5) * 4096 + t * 64 + ((lc & 31) >> 3) * 16) = pk; }
                win[0] = win[1]; win[1] = win[2]; win[2] = cur;
            }
        }
        WG_BAR();
        {
            const int lp = ((lane >> 4) & 1) * 32 + (lane & 3) * 8 + (4 * hi + ((lane & 15) >> 2)) * 64;
#pragma unroll 1
            for (int i = 0; i < 6; ++i) {
                const int k = w * 6 + i, hh = k >> 3, pb = (k >> 2) & 1, nb = k & 3;
                const LAS unsigned char* ap = lds + S1_XS + (hh * 2 + pb) * 4096 + lp; const LAS unsigned char* bp = lds + S1_BM + nb * 4096 + lp;
                f32x16 acc = (f32x16){};
#pragma unroll
                for (int ks = 0; ks < 4; ++ks) { const bf16x8 af = cat8(vtr(ap + ks * 1024), vtr(ap + ks * 1024 + 512)), bf = cat8(vtr(bp + ks * 1024), vtr(bp + ks * 1024 + 512));
                    acc = MFMA32(af, bf, acc); }
                bf16_t* dst = ST + (((size_t)b * NCH + c) * 12 + g * 6 + hh) * 8192 + (size_t)(32 * pb) * 128 + 32 * nb + r32;
#pragma unroll
                for (int r = 0; r < 16; ++r) dst[crow(r, hi) * 128] = (bf16_t)(cvtpk(acc[r], 0.f) & 0xffffu);
            }
        }
        WG_BAR();
    }
}

__device__ __forceinline__ void phase_ssd_scan(Frame& F) {
    const bf16_t* ST = (const bf16_t*)(F.ws + WS_STATES); bf16_t* HIN = (bf16_t*)(F.ws + WS_HIN); const float* CD = (const float*)(F.ws + WS_CD);
    for (int e = F.vcu * NTHREADS + F.tid; e < BATCH * 12 * 2048; e += F.G * NTHREADS) {
        const int b = e / 24576, rem = e - b * 24576, h = rem >> 11, pn = rem & 2047;
        float c0 = 0.f, c1 = 0.f, c2 = 0.f, c3 = 0.f;
#pragma unroll 8
        for (int c = 0; c < NCH; ++c) {
            const size_t o = (((size_t)b * NCH + c) * 12 + h) * 8192 + pn * 4;
            const u32x2 s = *(const u32x2*)(ST + o); const float d = CD[((size_t)b * NCH + c) * 12 + h];
            u32x2 hv; hv.x = cvtpk(c0, c1); hv.y = cvtpk(c2, c3); *(u32x2*)(HIN + o) = hv;
            c0 = c0 * d + bflo(s.x); c1 = c1 * d + bfhi(s.x); c2 = c2 * d + bflo(s.y); c3 = c3 * d + bfhi(s.y);
        }
    }
}

constexpr int S3_XI = 0, S3_ZI = 49152, S3_BI = 98304, S3_CI = 114688;
__device__ __forceinline__ void phase_ssd_out(Frame& F) {
    LAS unsigned char* lds = F.lds; const float* const* in = F.in;
    const bf16_t* U = (const bf16_t*)(F.ws + WS_U); const bf16_t* CONV = (const bf16_t*)(F.ws + WS_CONV); const bf16_t* HIN = (const bf16_t*)(F.ws + WS_HIN);
    const float* DTC = (const float*)(F.ws + WS_DTC); bf16_t* MIX = (bf16_t*)(F.ws + WS_MIX);
    const int lane = F.lane, w = F.wave, tid = F.tid, r32 = lane & 31, hi = lane >> 5, tb = w & 1, wq = w >> 1;
    const unsigned lds0 = (unsigned)(uintptr_t)lds;
    for (int unit = F.vcu; unit < BATCH * NCH * 2; unit += F.G) {
        const int g = unit & 1, c = (unit >> 1) & 63, b = unit >> 7;
        const size_t r0 = (size_t)b * SEQ + c * 64;
#pragma unroll 1
        for (int i = 0; i < 16; ++i) {
            const int pc = w * 16 + i;
            if (pc < 48) { const int blk = pc >> 2, rg = pc & 3; glds16(CONV + (r0 + 16 * rg + (lane >> 2)) * SSM_CONV + g * 384 + 32 * blk + 8 * (lane & 3), (unsigned)__builtin_amdgcn_readfirstlane(lds0 + S3_XI + pc * 1024)); }
            else if (pc < 96) { const int q = pc - 48, blk = q >> 2, rg = q & 3; glds16(U + (r0 + 16 * rg + (lane >> 2)) * NPROJ + g * 384 + 32 * blk + 8 * (lane & 3), (unsigned)__builtin_amdgcn_readfirstlane(lds0 + S3_ZI + q * 1024)); }
            else if (pc < 112) { const int q = pc - 96; glds16(CONV + (r0 + lane) * SSM_CONV + 768 + g * 128 + 8 * q, (unsigned)__builtin_amdgcn_readfirstlane(lds0 + S3_BI + q * 1024)); }
            else { const int q = pc - 112; glds16(CONV + (r0 + lane) * SSM_CONV + 1024 + g * 128 + 8 * q, (unsigned)__builtin_amdgcn_readfirstlane(lds0 + S3_CI + q * 1024)); }
        }
        if (w < 6) { const int h = g * 6 + w; const size_t row = r0 + lane;
            ((LAS float*)(lds + LC_DTS))[w * 64 + lane] = DTC[row * 24 + h * 2]; ((LAS float*)(lds + LC_CUM))[w * 64 + lane] = DTC[row * 24 + h * 2 + 1]; }
        if (tid < 384) ((LAS float*)(lds + LC_NG))[tid] = in[I_SSMNG][g * 384 + tid];
        WG_BAR();
        f32x16 cb[2]; cb[0] = (f32x16){}; cb[1] = (f32x16){};
        const LAS unsigned char* cpt = lds + S3_CI + hi * 1024 + (32 * tb + r32) * 16;
        {
            const LAS unsigned char* bpt = lds + S3_BI + hi * 1024 + r32 * 16;
#pragma unroll
            for (int kn = 0; kn < 8; ++kn) { const bf16x8 cf = *(const LAS bf16x8*)(cpt + kn * 2048);
                cb[0] = MFMA32(*(const LAS bf16x8*)(bpt + kn * 2048), cf, cb[0]); cb[1] = MFMA32(*(const LAS bf16x8*)(bpt + kn * 2048 + 512), cf, cb[1]); }
        }
        const int t = 32 * tb + r32;
        const int lp = ((lane >> 4) & 1) * 32 + (lane & 3) * 8 + (4 * hi + ((lane & 15) >> 2)) * 64;
        float ss = 0.f;
#pragma unroll 1
        for (int i = 0; i < 3; ++i) {
            const int pi = 3 * wq + i, hh = pi >> 1, pb = pi & 1, h = g * 6 + hh;
            const float cum_t = ((const LAS float*)(lds + LC_CUM))[hh * 64 + t];
            f32x16 acc = (f32x16){};
            const bf16_t* hp = HIN + (((size_t)b * NCH + c) * 12 + h) * 8192 + (size_t)(32 * pb + r32) * 128 + 8 * hi;
#pragma unroll
            for (int kn = 0; kn < 8; ++kn) acc = MFMA32(*(const bf16x8*)(hp + 16 * kn), *(const LAS bf16x8*)(cpt + kn * 2048), acc);
            const float et = expf(cum_t);
#pragma unroll
            for (int r = 0; r < 16; ++r) acc[r] *= et;
            u32x4 pw[4];
#pragma unroll
            for (int sb = 0; sb < 2; ++sb)
#pragma unroll
                for (int q = 0; q < 4; ++q) {
                    float wv[4];
#pragma unroll
                    for (int e = 0; e < 4; ++e) { const int r = 4 * q + e, s = 32 * sb + crow(r, hi);
                        const float cs = ((const LAS float*)(lds + LC_CUM))[hh * 64 + s], ds = ((const LAS float*)(lds + LC_DTS))[hh * 64 + s];
                        wv[e] = (s <= t) ? cb[sb][r] * expf(cum_t - cs) * ds : 0.f; }
                    pw[2 * sb + (q >> 1)][(q & 1) * 2] = cvtpk(wv[0], wv[1]); pw[2 * sb + (q >> 1)][(q & 1) * 2 + 1] = cvtpk(wv[2], wv[3]);
                }
            const LAS unsigned char* xp = lds + S3_XI + (hh * 2 + pb) * 4096 + lp;
#pragma unroll
            for (int ks = 0; ks < 4; ++ks) acc = MFMA32(cat8(vtr(xp + ks * 1024), vtr(xp + ks * 1024 + 512)), __builtin_bit_cast(bf16x8, pw[ks]), acc);
            const float dsk = in[I_SSMD][h];
            const LAS unsigned char* xr = lds + S3_XI + (hh * 2 + pb) * 4096 + t * 64 + 8 * hi; LAS unsigned char* zr = lds + S3_ZI + (hh * 2 + pb) * 4096 + t * 64 + 8 * hi;
#pragma unroll
            for (int q = 0; q < 4; ++q) { const u32x2 xv = *(const LAS u32x2*)(xr + 16 * q), zv = *(const LAS u32x2*)(zr + 16 * q);
                const float v0 = (acc[4 * q] + dsk * bflo(xv.x)) * silu_f(bflo(zv.x)), v1 = (acc[4 * q + 1] + dsk * bfhi(xv.x)) * silu_f(bfhi(zv.x));
                const float v2 = (acc[4 * q + 2] + dsk * bflo(xv.y)) * silu_f(bflo(zv.y)), v3 = (acc[4 * q + 3] + dsk * bfhi(xv.y)) * silu_f(bfhi(zv.y));
                ss += (v0 * v0 + v1 * v1) + (v2 * v2 + v3 * v3);
                u32x2 yv; yv.x = cvtpk(v0, v1); yv.y = cvtpk(v2, v3); *(LAS u32x2*)(zr + 16 * q) = yv; }
        }
        ss += __shfl_xor(ss, 32);
        if (hi == 0) ((LAS float*)(lds + LC_PART))[wq * 64 + t] = ss;
        WG_BAR();
        { const LAS float* pp = (const LAS float*)(lds + LC_PART); const float tot = (pp[t] + pp[64 + t]) + (pp[128 + t] + pp[192 + t]);
          const float rs = 1.0f / sqrtf(tot * (1.0f / 384.0f) + EPS);
          bf16_t* orow = MIX + (r0 + t) * DM + g * 384;
#pragma unroll 1
          for (int i = 0; i < 3; ++i) { const int pi = 3 * wq + i, hh = pi >> 1, pb = pi & 1;
              const LAS unsigned char* zr = lds + S3_ZI + (hh * 2 + pb) * 4096 + t * 64 + 8 * hi;
#pragma unroll
              for (int q = 0; q < 4; ++q) { const int lc = 64 * hh + 32 * pb + 8 * q + 4 * hi; const f32x4 gg = *(const LAS f32x4*)(lds + LC_NG + lc * 4);
                  const u32x2 yv = *(const LAS u32x2*)(zr + 16 * q);
                  u32x2 wv; wv.x = cvtpk(bflo(yv.x) * rs * gg.x, bfhi(yv.x) * rs * gg.y); wv.y = cvtpk(bflo(yv.y) * rs * gg.z, bfhi(yv.y) * rs * gg.w);
                  *(u32x2*)(orow + lc) = wv; } } }
        WG_BAR();
    }
}

constexpr int LC_LCNT = MISC_OFF + 128;
__device__ __forceinline__ void phase_route(Frame& F) {
    const float* const* in = F.in; LAS unsigned char* lds = F.lds;
    bf16_t* XNM = (bf16_t*)(F.ws + WS_XNM); i32x4* ROUTE = (i32x4*)(F.ws + WS_ROUTE); f32x2* GATE = (f32x2*)(F.ws + WS_GATE);
    const int lane = F.lane, w = F.wave;
    const float* g = in[I_LN2G] + DM; const float* Wr = in[I_ROUTER];
    for (int blk = F.vcu; blk < T / 64; blk += F.G) {
        if (F.tid < 8) ((LAS int*)(lds + LC_LCNT))[F.tid] = 0;
        WG_BAR();
#pragma unroll 1
        for (int i = 0; i < 8; ++i) {
            const size_t row = (size_t)blk * 64 + w * 8 + i;
            const GAS f32x4* xr = (const GAS f32x4*)(F.out + row * DM) + lane; const GAS f32x4* gr = (const GAS f32x4*)g + lane;
            f32x4 v[4]; float s = 0.f;
#pragma unroll
            for (int j = 0; j < 4; ++j) { v[j] = xr[64 * j]; s += (v[j].x * v[j].x + v[j].y * v[j].y) + (v[j].z * v[j].z + v[j].w * v[j].w); }
            const float rstd = 1.0f / sqrtf(wave_sum(s) * (1.f / DM) + EPS);
            float lg[8];
#pragma unroll
            for (int e = 0; e < 8; ++e) lg[e] = 0.f;
            GAS u32x2* o8 = (GAS u32x2*)(XNM + row * DM) + lane;
#pragma unroll
            for (int j = 0; j < 4; ++j) { const f32x4 gg = gr[64 * j]; const f32x4 hn = {v[j].x * rstd * gg.x, v[j].y * rstd * gg.y, v[j].z * rstd * gg.z, v[j].w * rstd * gg.w};
                u32x2 wv; wv.x = cvtpk(hn.x, hn.y); wv.y = cvtpk(hn.z, hn.w); o8[64 * j] = wv;
                const float* wp = Wr + (size_t)(256 * j + 4 * lane) * 8;
#pragma unroll
                for (int q = 0; q < 4; ++q) { const f32x4 w0 = *(const f32x4*)(wp + 8 * q), w1 = *(const f32x4*)(wp + 8 * q + 4); const float hq = hn[q];
                    lg[0] += hq * w0.x; lg[1] += hq * w0.y; lg[2] += hq * w0.z; lg[3] += hq * w0.w; lg[4] += hq * w1.x; lg[5] += hq * w1.y; lg[6] += hq * w1.z; lg[7] += hq * w1.w; } }
#pragma unroll
            for (int e = 0; e < 8; ++e) lg[e] = wave_sum(lg[e]);
            int e0 = 0; float v0 = lg[0];
#pragma unroll
            for (int e = 1; e < 8; ++e) if (lg[e] > v0) { v0 = lg[e]; e0 = e; }
            int e1 = -1; float v1 = -3.0e38f;
#pragma unroll
            for (int e = 0; e < 8; ++e) if (e != e0 && lg[e] > v1) { v1 = lg[e]; e1 = e; }
            if (lane == 0) {
                const float g0 = 1.0f / (1.0f + expf(v1 - v0));
                const int lr0 = __hip_atomic_fetch_add((LAS int*)(lds + LC_LCNT) + e0, 1, __ATOMIC_RELAXED, __HIP_MEMORY_SCOPE_WORKGROUP), lr1 = __hip_atomic_fetch_add((LAS int*)(lds + LC_LCNT) + e1, 1, __ATOMIC_RELAXED, __HIP_MEMORY_SCOPE_WORKGROUP);
                ROUTE[row] = (i32x4){e0, lr0, e1, lr1}; GATE[row] = (f32x2){g0, 1.0f - g0};
            }
        }
        WG_BAR();
        if (F.tid < 8) F.ctl[CW_CNT + blk * 8 + F.tid] = (unsigned)((LAS int*)(lds + LC_LCNT))[F.tid];
        WG_BAR();
    }
}
__device__ __forceinline__ void phase_gather(Frame& F) {
    LAS unsigned char* lds = F.lds;
    const bf16_t* XNM = (const bf16_t*)(F.ws + WS_XNM); bf16_t* HP = (bf16_t*)(F.ws + WS_HPERM); i32x4* ROUTE = (i32x4*)(F.ws + WS_ROUTE);
    const int lane = F.lane, w = F.wave;
    for (int blk = F.vcu; blk < T / 64; blk += F.G) {
        { int tot = 0, pre = 0;
#pragma unroll
          for (int k = 0; k < 4; ++k) { const int bi = lane + 64 * k; const int cnt = (int)F.ctl[CW_CNT + bi * 8 + w]; tot += cnt; pre += (bi < blk) ? cnt : 0; }
#pragma unroll
          for (int o = 1; o < 64; o <<= 1) { tot += __shfl_xor(tot, o); pre += __shfl_xor(pre, o); }
          if (lane == 0) { ((LAS int*)(lds + LC_LCNT))[8 + w] = tot; ((LAS int*)(lds + LC_LCNT))[16 + w] = pre; } }
        WG_BAR();
        int base[8], off[9]; off[0] = 0;
#pragma unroll
        for (int e = 0; e < 8; ++e) { const int tot = ((LAS int*)(lds + LC_LCNT))[8 + e]; off[e + 1] = off[e] + ((tot + 255) & ~255); base[e] = off[e] + ((LAS int*)(lds + LC_LCNT))[16 + e]; }
#pragma unroll 1
        for (int i = 0; i < 8; ++i) {
            const size_t row = (size_t)blk * 64 + w * 8 + i;
            const i32x4 rt = ROUTE[row];
            int s0 = rt.y, s1 = rt.w;
#pragma unroll
            for (int e = 0; e < 8; ++e) { if (rt.x == e) s0 += base[e]; if (rt.z == e) s1 += base[e]; }
            const u32x4* src = (const u32x4*)(XNM + row * DM) + lane; const u32x4 a = src[0], c = src[64];
            u32x4* d0 = (u32x4*)(HP + (size_t)s0 * DM) + lane; u32x4* d1 = (u32x4*)(HP + (size_t)s1 * DM) + lane;
            d0[0] = a; d0[64] = c; d1[0] = a; d1[64] = c;
            if (lane == 0) ROUTE[row] = (i32x4){s0, s1, 0, 0};
        }
        if (blk < 8) {
            const int e = blk; int tot = ((LAS int*)(lds + LC_LCNT))[8 + e]; int lo = 0, hi_ = 0;
#pragma unroll
            for (int q = 0; q < 8; ++q) if (q == e) { lo = off[q] + tot; hi_ = off[q + 1]; }
            for (int r = lo + (F.tid >> 7); r < hi_; r += 4) *((u32x4*)(HP + (size_t)r * DM) + (F.tid & 127)) = (u32x4){0u, 0u, 0u, 0u};
            if (blk == 0 && F.tid == 0) {
                F.ctl[CW_NTILES] = (unsigned)(off[8] >> 8);
#pragma unroll
                for (int q = 0; q < 8; ++q) for (int tix = off[q] >> 8; tix < (off[q + 1] >> 8); ++tix) F.ctl[CW_TILE_E + tix] = (unsigned)q;
            }
        }
        WG_BAR();
    }
}
__device__ __forceinline__ void phase_combine(Frame& F) {
    const bf16_t* Y = (const bf16_t*)(F.ws + WS_HPERM); const i32x4* ROUTE = (const i32x4*)(F.ws + WS_ROUTE); const f32x2* GATE = (const f32x2*)(F.ws + WS_GATE);
    const int gw = F.vcu * NWAVES + F.wave, NGW = F.G * NWAVES, lane = F.lane;
    for (int m = gw; m < T; m += NGW) {
        const i32x4 rt = ROUTE[m]; const f32x2 gt = GATE[m];
        GAS f32x4* o = (GAS f32x4*)(F.out + (size_t)m * DM) + lane;
        const GAS u32x2* y0 = (const GAS u32x2*)(Y + (size_t)rt.x * DM) + lane; const GAS u32x2* y1 = (const GAS u32x2*)(Y + (size_t)rt.y * DM) + lane;
#pragma unroll
        for (int j = 0; j < 4; ++j) { f32x4 v = o[64 * j]; const u32x2 a = y0[64 * j], c = y1[64 * j];
            v.x += gt.x * bflo(a.x) + gt.y * bflo(c.x); v.y += gt.x * bfhi(a.x) + gt.y * bfhi(c.x); v.z += gt.x * bflo(a.y) + gt.y * bflo(c.y); v.w += gt.x * bfhi(a.y) + gt.y * bfhi(c.y);
            o[64 * j] = v; }
    }
}

constexpr int NPH_ALL = 19;
constexpr int NPH = (MK_LEVEL == 0) ? 1 : (MK_LEVEL == 1) ? 4 : (MK_LEVEL == 2) ? 7 : (MK_LEVEL == 3) ? 13 : NPH_ALL;
struct Args { const float* in[N_IN]; float* out; unsigned char* ws; int ph_lo, ph_hi; };
static_assert(sizeof(Args) == N_IN * 8 + 24, "Args has no padding");

__global__ void __launch_bounds__(NTHREADS, 2) fwd(Args a) {
    extern __shared__ __attribute__((aligned(16))) unsigned char lds_raw[];
    Frame F;
    F.lds = (LAS unsigned char*)lds_raw;
    F.tid = threadIdx.x; F.lane = F.tid & 63; F.wave = __builtin_amdgcn_readfirstlane(F.tid >> 6);
    F.G = gridDim.x; { const int bx = blockIdx.x; F.vcu = (F.G % 8 == 0) ? (bx % 8) * (F.G / 8) + bx / 8 : bx; }
    F.ws = a.ws; F.ctl = (gu32*)(a.ws + WS_CTL); F.in = a.in; F.out = a.out;
    for (int u = F.tid; u < (LDS_BYTES - MISC_OFF) / 4; u += NTHREADS) ((LAS unsigned*)(F.lds + MISC_OFF))[u] = 0u;
    __syncthreads();
#if MK_ONE_LAUNCH
    XcdBarrier bar = xcd_barrier_post((unsigned*)(F.ctl + CW_BAR), (volatile LAS unsigned*)(F.lds + MISC_OFF + 32));
#define GRID_BAR() xcd_barrier(bar)
#else
#define GRID_BAR() do {} while (0)
#endif
    const int lo = a.ph_lo, hi = a.ph_hi;
#define IN(k) ((k) < NPH && lo <= (k) && (k) < hi)
#define SEAM(k) do { if (IN(k) && IN((k) + 1)) GRID_BAR(); } while (0)
    unsigned char* ws = a.ws;
    const int cidx = (int)blockIdx.x;

    if (IN(0)) { phase_prologue(F); } SEAM(0);

    if (IN(1)) {
        lds_load_vec64(F, LC_QG, F.in[I_DAQNG]); lds_load_vec64(F, LC_KG, F.in[I_DAKNG]); lds_load_vec64(F, LC_MQG, F.in[I_MQNG]);
        lds_load_vec64(F, LC_MKG0, F.in[I_MKNG]); lds_load_vec64(F, LC_MKG1, F.in[I_MKNG] + 64);
        WG_BAR();
        SchedP1 S; S.so.init(T, NPROJ, F.G, cidx); S.ws = (const char*)ws;
        EpiProj<CfgP1> E{CfgP1{(bf16_t*)(ws + WS_U), (bf16_t*)(ws + WS_KVM)}, F.lds};
        pg8::gemm_phase<EpiProj<CfgP1>, SchedP1, true, true>(F.lds, DM, S, E);
    } SEAM(1);

    if (IN(2)) { phase_attn0(F); } SEAM(2);

    if (IN(3)) {
        SchedPlain S; S.init(T, DM, F.G, cidx); S.A = (const char*)(ws + WS_MIX); S.B = (const char*)(ws + WS_WOUT0); S.ta = 256 * DM * 2; S.tb = 256 * DM * 2;
        EpiResid E{F.in[I_X], F.out};
        pg8::gemm_phase<EpiResid, SchedPlain, true, true>(F.lds, DM, S, E);
    } SEAM(3);

    if (IN(4)) { phase_rownorm(F, F.in[I_LN2G], (bf16_t*)(ws + WS_XN)); } SEAM(4);

    if (IN(5)) {
        SchedPlain S; S.init(T, 2 * FFN, F.G, cidx); S.A = (const char*)(ws + WS_XN); S.B = (const char*)(ws + WS_WGU); S.ta = 256 * DM * 2; S.tb = 256 * DM * 2;
        EpiSwiGLU E{(bf16_t*)(ws + WS_ACT), FFN};
        pg8::gemm_phase<EpiSwiGLU, SchedPlain, true, true>(F.lds, DM, S, E);
    } SEAM(5);

    if (IN(6)) {
        SchedPlain S; S.init(T, DM, F.G, cidx); S.A = (const char*)(ws + WS_ACT); S.B = (const char*)(ws + WS_WDN); S.ta = (size_t)256 * FFN * 2; S.tb = (size_t)256 * FFN * 2;
        EpiResid E{F.out, F.out};
        pg8::gemm_phase<EpiResid, SchedPlain, true, true>(F.lds, FFN, S, E);
    } SEAM(6);

    if (IN(7)) { phase_rownorm(F, F.in[I_LN1G] + DM, (bf16_t*)(ws + WS_XN)); } SEAM(7);

    if (IN(8)) {
        lds_load_vec64(F, LC_MQG, F.in[I_MQNG] + 64);
        WG_BAR();
        SchedPlain S; S.init(T, NPROJ, F.G, cidx); S.A = (const char*)(ws + WS_XN); S.B = (const char*)(ws + WS_WSSM); S.ta = 256 * DM * 2; S.tb = 256 * DM * 2;
        EpiProj<CfgP8> E{CfgP8{(bf16_t*)(ws + WS_U), (float*)(ws + WS_DT)}, F.lds};
        pg8::gemm_phase<EpiProj<CfgP8>, SchedPlain, true, true>(F.lds, DM, S, E);
    } SEAM(8);

    if (IN(9)) { phase_ssd_local(F); phase_memattn1(F); } SEAM(9);
    if (IN(10)) { phase_ssd_scan(F); } SEAM(10);
    if (IN(11)) { phase_ssd_out(F); } SEAM(11);

    if (IN(12)) {
        SchedPlain S; S.init(T, DM, F.G, cidx); S.A = (const char*)(ws + WS_MIX); S.B = (const char*)(ws + WS_WOUT1); S.ta = 256 * DM * 2; S.tb = 256 * DM * 2;
        EpiResid E{F.out, F.out};
        pg8::gemm_phase<EpiResid, SchedPlain, true, true>(F.lds, DM, S, E);
    } SEAM(12);

    if (IN(13)) { phase_route(F); } SEAM(13);
    if (IN(14)) { phase_gather(F); } SEAM(14);

    if (IN(15)) {
        const int ntiles = (int)F.ctl[CW_NTILES];
        SchedMoe S; S.init(ntiles * 256, 2 * EXD, F.G, cidx); S.A = (const char*)(ws + WS_HPERM); S.B = (const char*)(ws + WS_WMGU); S.ta = 256 * DM * 2; S.tb = 256 * DM * 2; S.eb = (size_t)2 * EXD * DM * 2;
        S.tile_e = (const int*)(const unsigned*)(F.ctl + CW_TILE_E);
        EpiSwiGLU E{(bf16_t*)(ws + WS_ACTM), EXD};
        pg8::gemm_phase<EpiSwiGLU, SchedMoe, true, true>(F.lds, DM, S, E);
    } SEAM(15);

    if (IN(16)) { phase_cvt_moe_down(F); } SEAM(16);

    if (IN(17)) {
        const int ntiles = (int)F.ctl[CW_NTILES];
        SchedMoe S; S.init(ntiles * 256, DM, F.G, cidx); S.A = (const char*)(ws + WS_ACTM); S.B = (const char*)(ws + WS_WMGU); S.ta = (size_t)256 * EXD * 2; S.tb = (size_t)256 * EXD * 2; S.eb = (size_t)DM * EXD * 2;
        S.tile_e = (const int*)(const unsigned*)(F.ctl + CW_TILE_E);
        EpiBf16 E{(bf16_t*)(ws + WS_HPERM), DM};
        pg8::gemm_phase<EpiBf16, SchedMoe, true, true>(F.lds, EXD, S, E);
    } SEAM(17);

    if (IN(18)) { phase_combine(F); }
#undef IN
#undef SEAM
}

extern "C" void kernel_launch(void* const* d_in, const int* in_sizes, int n_in, void* d_out, int out_size, void* d_ws, size_t ws_size, hipStream_t stream) {
    static int grid = 0;
    if (grid == 0) {
        if (n_in != N_IN || out_size != T * DM || ws_size < WS_END) { fprintf(stderr, "kernel_launch: unexpected problem shape (n_in %d, out %d, ws %zu)\n", n_in, out_size, ws_size); grid = -1; return; }
        int dev = 0, cus = 0, per_cu = 0;
        if (hipGetDevice(&dev) != hipSuccess || hipDeviceGetAttribute(&cus, hipDeviceAttributeMultiprocessorCount, dev) != hipSuccess) { grid = -1; return; }
        if (hipFuncSetAttribute((const void*)fwd, hipFuncAttributeMaxDynamicSharedMemorySize, LDS_BYTES) != hipSuccess) { fprintf(stderr, "kernel_launch: hipFuncSetAttribute failed\n"); grid = -1; return; }
        if (hipOccupancyMaxActiveBlocksPerMultiprocessor(&per_cu, (const void*)fwd, NTHREADS, LDS_BYTES) != hipSuccess || per_cu < 1) fprintf(stderr, "kernel_launch: occupancy query reports %d\n", per_cu);
        (void)hipGetLastError();
        grid = cus;
    }
    if (grid < 0) return;
    if (hipMemsetAsync((char*)d_ws + WS_CTL, 0, CTL_ZERO_BYTES, stream) != hipSuccess) return;
    Args a{};
    for (int i = 0; i < N_IN; ++i) a.in[i] = (const float*)d_in[i];
    a.out = (float*)d_out; a.ws = (unsigned char*)d_ws;
#if MK_ONE_LAUNCH
    a.ph_lo = 0; a.ph_hi = NPH;
    hipLaunchKernelGGL(fwd, dim3(grid), dim3(NTHREADS), LDS_BYTES, stream, a);
#else
    for (int p = 0; p < NPH; ++p) { a.ph_lo = p; a.ph_hi = p + 1; hipLaunchKernelGGL(fwd, dim3(grid), dim3(NTHREADS), LDS_BYTES, stream, a); }
#endif
}
```

```cpp
#include <hip/hip_runtime.h>
#include <cstdio>
#include <cstdint>

#ifndef MK_LEVEL
#define MK_LEVEL 4
#endif
#ifndef MK_ONE_LAUNCH
#define MK_ONE_LAUNCH 1
#endif

#ifndef MK_PROBE_LO
#define MK_PROBE_LO -1
#define MK_PROBE_HI -1
#endif
#define MK_PROBE_MULT 4


constexpr int NWAVES = 8, NTHREADS = 512;
constexpr int BATCH = 4, SEQ = 4096, DM = 1024, T = BATCH * SEQ;
constexpr int MEM_LEN = 256, MEMROWS = BATCH * MEM_LEN;
constexpr int TOK_W = 768, MEM_W = 256, NPROJ = 2560;
constexpr int DA_HEADS = 6, SSM_HEADS = 12, SSM_CONV = 1280, SSM_IN = 2316;
constexpr int FFN = 2816, EXD = 3584, NEXP = 8;
constexpr int CHUNK = 64, NCH = SEQ / CHUNK;
constexpr float EPS = 1e-6f, LOG2E = 1.4426950408889634f;
constexpr int MOE_MAXTILES = 136;
constexpr int MOE_ROWS = MOE_MAXTILES * 256;

constexpr size_t MiB = 1u << 20;
constexpr size_t WS_CTL = 0, CTL_ZERO_BYTES = 1 * MiB;
constexpr size_t WS_WDA = 1 * MiB;
constexpr size_t WS_WOUT0 = 6 * MiB, WS_WOUT1 = 8 * MiB;
constexpr size_t WS_WKV0 = 10 * MiB, WS_WKV1 = 11 * MiB;
constexpr size_t WS_WSSM = 12 * MiB;
constexpr size_t WS_WGU = 17 * MiB;
constexpr size_t WS_WDN = 28 * MiB;
constexpr size_t WS_WMGU = 34 * MiB;
constexpr size_t WS_WMDN = 90 * MiB;
constexpr size_t WS_R = 146 * MiB;
constexpr size_t WS_XN = WS_R;
constexpr size_t WS_U = WS_R + 32 * MiB;
constexpr size_t WS_MIX = WS_R + 112 * MiB;
constexpr size_t WS_ACT = WS_R + 144 * MiB;
constexpr size_t WS_CONV = WS_R + 144 * MiB;
constexpr size_t WS_STATES = WS_R + 184 * MiB;
constexpr size_t WS_HIN = WS_R + 232 * MiB;
constexpr size_t WS_KVM = WS_R + 280 * MiB;
constexpr size_t WS_MEMN = WS_R + 282 * MiB;
constexpr size_t WS_DT = WS_R + 284 * MiB;
constexpr size_t WS_DTC = WS_R + 285 * MiB;
constexpr size_t WS_CD = WS_R + 287 * MiB;
constexpr size_t WS_HPERM = WS_R;
constexpr size_t WS_ACTM = WS_R + 34 * MiB;
constexpr size_t WS_Y = WS_R + 154 * MiB;
constexpr size_t WS_XNM = WS_R + 224 * MiB;
constexpr size_t WS_ROUTE = WS_R + 306 * MiB;
constexpr size_t WS_GATE = WS_R + 307 * MiB;
constexpr size_t WS_END = WS_R + 308 * MiB;
static_assert(WS_ACTM + (size_t)MOE_ROWS * EXD <= WS_Y && WS_Y + (size_t)MOE_ROWS * DM * 2 <= WS_XNM && WS_XNM + (size_t)T * DM <= WS_ROUTE, "MoE map");
static_assert(WS_WMDN + (size_t)NEXP * DM * EXD <= WS_R, "fp8 weights fit");
static_assert(WS_STATES + (size_t)BATCH * NCH * SSM_HEADS * 64 * 128 * 2 <= WS_HIN && WS_HIN + (size_t)BATCH * NCH * SSM_HEADS * 64 * 128 * 2 <= WS_KVM, "STATES/HIN fit");
static_assert(WS_U + (size_t)T * NPROJ * 2 <= WS_MIX && WS_MIX + (size_t)T * DM * 2 <= WS_ACT && WS_ACT + (size_t)T * FFN * 2 <= WS_KVM, "layer-0 map");
static_assert(WS_END <= 468 * MiB, "workspace");

constexpr int CW_BAR = 4096;
constexpr int CW_Q0 = 8192, CW_Q1 = 8256;
constexpr int CW_CNT = 16384;
constexpr int CW_NTILES = 20480;
constexpr int CW_TILE_E = 20544;

constexpr int RING_BYTES = 131072;
constexpr int CONST_OFF = RING_BYTES;
constexpr int MISC_OFF = CONST_OFF + 8192;
constexpr int LDS_BYTES = 147456;

#define GAS __attribute__((address_space(1)))
#define LAS __attribute__((address_space(3)))
typedef unsigned short bf16_t;
typedef short bf16x8 __attribute__((ext_vector_type(8)));
typedef short s16x4 __attribute__((ext_vector_type(4)));
typedef float f32x2 __attribute__((ext_vector_type(2)));
typedef float f32x4 __attribute__((ext_vector_type(4)));
typedef float f32x16 __attribute__((ext_vector_type(16)));
typedef unsigned u32x2 __attribute__((ext_vector_type(2)));
typedef unsigned u32x4 __attribute__((ext_vector_type(4)));
typedef int i32x4 __attribute__((ext_vector_type(4)));
typedef GAS unsigned gu32;
#define RLX_AGENT __ATOMIC_RELAXED, __HIP_MEMORY_SCOPE_AGENT
#define LDS_WAIT() asm volatile("s_waitcnt lgkmcnt(0)" ::: "memory")
#define VM_WAIT() asm volatile("s_waitcnt vmcnt(0)" ::: "memory")
#define WG_BAR() asm volatile("s_waitcnt vmcnt(0) lgkmcnt(0)\n\ts_barrier" ::: "memory")

typedef __bf16 bf16x2_t __attribute__((ext_vector_type(2)));
__device__ __forceinline__ unsigned cvtpk(float lo, float hi) { f32x2 v = {lo, hi}; bf16x2_t b = __builtin_convertvector(v, bf16x2_t); return __builtin_bit_cast(unsigned, b); }
__device__ __forceinline__ float clamp448(float x) { return __builtin_fminf(__builtin_fmaxf(x, -448.0f), 448.0f); }
__device__ __forceinline__ unsigned pack4_fp8(float a, float b, float c, float d) {
    unsigned w = 0u; w = (unsigned)__builtin_amdgcn_cvt_pk_fp8_f32(clamp448(a), clamp448(b), (int)w, false); w = (unsigned)__builtin_amdgcn_cvt_pk_fp8_f32(clamp448(c), clamp448(d), (int)w, true); return w; }
__device__ __forceinline__ float bf2f(unsigned short b) { return __uint_as_float((unsigned)b << 16); }
__device__ __forceinline__ float bflo(unsigned w) { return __uint_as_float(w << 16); }
__device__ __forceinline__ float bfhi(unsigned w) { return __uint_as_float(w & 0xffff0000u); }
__device__ __forceinline__ float wave_sum(float v) {
#pragma unroll
    for (int o = 1; o < 64; o <<= 1) v += __shfl_xor(v, o);
    return v;
}
__device__ __forceinline__ float fast_exp2(float x) { return __builtin_amdgcn_exp2f(x); }
__device__ __forceinline__ float fast_rcp(float x) { return __builtin_amdgcn_rcpf(x); }
__device__ __forceinline__ float silu_f(float x) { return x * fast_rcp(1.0f + fast_exp2(-x * LOG2E)); }
__device__ __forceinline__ int crow(int r, int hi) { return (r & 3) + 8 * (r >> 2) + 4 * hi; }
__device__ __forceinline__ void glds16(const void* gsrc, unsigned lds_dst) { unsigned keep;
    asm volatile("s_mov_b32 %0, m0\n\ts_mov_b32 m0, %2\n\ts_nop 0\n\tglobal_load_lds_dwordx4 %1, off\n\ts_mov_b32 m0, %0" : "=&s"(keep) : "v"(gsrc), "s"(lds_dst) : "memory"); }
typedef short v4i16_t __attribute__((ext_vector_type(4)));
__device__ __forceinline__ s16x4 vtr(const LAS unsigned char* p) { return __builtin_bit_cast(s16x4, __builtin_amdgcn_ds_read_tr16_b64_v4i16((LAS v4i16_t*)p)); }
__device__ __forceinline__ bf16x8 cat8(s16x4 lo, s16x4 hi) { return (bf16x8){lo[0], lo[1], lo[2], lo[3], hi[0], hi[1], hi[2], hi[3]}; }
#define MFMA32(a, b, c) __builtin_amdgcn_mfma_f32_32x32x16_bf16(a, b, c, 0, 0, 0)

namespace pg8 {
#define PG8_LAS __attribute__((address_space(3)))
typedef unsigned short bf16_t;
typedef short bf16x8 __attribute__((ext_vector_type(8)));
typedef float f32x4 __attribute__((ext_vector_type(4)));
typedef unsigned u32x4 __attribute__((ext_vector_type(4)));
constexpr int BM = 256, BK = 64, HALF = 128, HTB = HALF * BK * 2  , STAGE_BYTES = 8 * HTB, NXCD = 8, WGM = 8;

__host__ __device__ __forceinline__ int lds_byte(int r, int c) { const int st = (r >> 4) * 2 + (c >> 5), rr = r & 15, cc = c & 31, ob = rr * 64 + cc * 2; return st * 1024 + (ob ^ (((ob >> 9) & 1) << 5)); }
__host__ __device__ __forceinline__ void stage_rc(int b, int& R, int& C) { const int st = b / 1024, sb = b % 1024, swz = sb ^ (((sb >> 9) & 1) << 5); R = (st >> 1) * 16 + swz / 64; C = (st & 1) * 32 + (swz % 64) / 2; }
__host__ __device__ __forceinline__ int perm32(int rho) { const int n = rho >> 4, i = rho & 15; return 8 * (i >> 2) + 4 * n + (i & 3); }

struct Unit { int pm, pn, aux; };

struct StaticOrder {
    int nM, nN, nwg, G, c;
    __host__ __device__ void init(int M, int N, int G_, int c_) { nM = M / BM; nN = N / BM; nwg = nM * nN; G = G_; c = c_; }
    __host__ __device__ bool next(int i, Unit& u) const {
        const long L = (long)i * G + c; if (L >= nwg) return false;
        int wgid = (int)L; { const int q = nwg / NXCD, r = nwg % NXCD, xcd = wgid % NXCD, off = wgid / NXCD; wgid = (xcd < r ? xcd * (q + 1) : r * (q + 1) + (xcd - r) * q) + off; }
        const int nig = WGM * nN, gid = wgid / nig, fm = gid * WGM, gsz = (nM - fm) < WGM ? (nM - fm) : WGM;
        u.pm = fm + ((wgid % nig) % gsz); u.pn = (wgid % nig) / gsz; return true;
    }
    __device__ __forceinline__ void a_ready(const Unit&) const {}
    __device__ __forceinline__ void done(const Unit&) const {}
};

typedef int i32x8 __attribute__((ext_vector_type(8)));
template <class Epi, class Sched, bool ALIGN_EPI = false, bool SP2 = false, bool F8 = false>
__device__ __forceinline__ void gemm_phase(PG8_LAS unsigned char* lds, const int K, const Sched& S, const Epi& E) {
    const int tid = threadIdx.x, wid = __builtin_amdgcn_readfirstlane(tid >> 6), lane = tid & 63, wr = wid >> 2, wc = wid & 3, fr = lane & 15, fq = lane >> 4;
    const int nt = F8 ? K / 128 : K / BK;
    unsigned voffA[2], voffB[2];
#pragma unroll
    for (int i = 0; i < 2; ++i) { int R, C; stage_rc(tid * 16 + i * 8192, R, C); const int Rb = Epi::PERM ? ((R & ~31) + perm32(R & 31)) : R;
        voffA[i] = F8 ? (unsigned)(R * K + C * 2) : (unsigned)(R * K + C) * 2u; voffB[i] = F8 ? (unsigned)(Rb * K + C * 2) : (unsigned)(Rb * K + C) * 2u; }
    const size_t kstep = (size_t)(BK * 2);
    const size_t hstep = (size_t)HALF * K * (F8 ? 1 : 2);
    const size_t tstep = 2 * hstep;
    const unsigned ldsw = (unsigned)wid * 1024u;
    const int aoff = lds_byte(wr * 64 + fr, fq * 8), boff = lds_byte(wc * 32 + fr, fq * 8);
    const int aoff8 = lds_byte(wr * 64 + fr, fq * 16), boff8 = lds_byte(wc * 32 + fr, fq * 16);
#define PG8_SA(b, h) (((b) * 2 + (h)) * HTB)
#define PG8_SB(b, h) ((4 + (b) * 2 + (h)) * HTB)
#define PG8_STAGE(bufoff, gbase, voff) do { _Pragma("unroll") for (int _i = 0; _i < 2; ++_i) \
        __builtin_amdgcn_global_load_lds((const unsigned*)((const char*)(gbase) + (voff)[_i]), (PG8_LAS unsigned*)(lds + (bufoff) + ldsw + _i * 8192), 16, 0, 0); } while (0)
typedef int i32x4v __attribute__((ext_vector_type(4)));
#define PG8_LD32(p) __builtin_shufflevector(*(const PG8_LAS i32x4v*)(p), *(const PG8_LAS i32x4v*)((p) + 16), 0, 1, 2, 3, 4, 5, 6, 7)
#define PG8_LDA(dst, b, h) do { if constexpr (F8) { _Pragma("unroll") for (int m = 0; m < 4; ++m) dst##8[m] = PG8_LD32(lds + PG8_SA(b, h) + aoff8 + m * 2048); } \
        else { _Pragma("unroll") for (int m = 0; m < 4; ++m) _Pragma("unroll") for (int k = 0; k < 2; ++k) dst[m][k] = *(const PG8_LAS bf16x8*)(lds + PG8_SA(b, h) + aoff + m * 2048 + k * 1024); } } while (0)
#define PG8_LDB(dst, b, h) do { if constexpr (F8) { _Pragma("unroll") for (int n = 0; n < 2; ++n) dst##8[n] = PG8_LD32(lds + PG8_SB(b, h) + boff8 + n * 2048); } \
        else { _Pragma("unroll") for (int n = 0; n < 2; ++n) _Pragma("unroll") for (int k = 0; k < 2; ++k) dst[n][k] = *(const PG8_LAS bf16x8*)(lds + PG8_SB(b, h) + boff + n * 2048 + k * 1024); } } while (0)
#define PG8_MMA(ai, bj, At, Bt) do { __builtin_amdgcn_s_setprio(1); if constexpr (F8) { _Pragma("unroll") for (int m = 0; m < 4; ++m) _Pragma("unroll") for (int n = 0; n < 2; ++n) \
        asm volatile("v_mfma_f32_16x16x128_f8f6f4 %0, %1, %2, %0" : "+v"(acc[ai][bj][m][n]) : "v"(Bt##8[n]), "v"(At##8[m])); } \
        else { _Pragma("unroll") for (int m = 0; m < 4; ++m) _Pragma("unroll") for (int n = 0; n < 2; ++n) _Pragma("unroll") for (int k = 0; k < 2; ++k) \
        acc[ai][bj][m][n] = __builtin_amdgcn_mfma_f32_16x16x32_bf16(Bt[n][k], At[m][k], acc[ai][bj][m][n], 0, 0, 0); } __builtin_amdgcn_s_setprio(0); } while (0)
#define PG8_WAIT_V(n) asm volatile("s_waitcnt vmcnt(" #n ")" ::: "memory")
#define PG8_WAIT_L(n) asm volatile("s_waitcnt lgkmcnt(" #n ")" ::: "memory")
#define PG8_BAR __builtin_amdgcn_s_barrier()
#define PG8_SCHED __builtin_amdgcn_sched_barrier(0)
    Unit cur, nxt; int ui = 0;
    if (!S.next(0, cur)) return;
    f32x4 acc[2][2][4][2];
#pragma unroll
    for (int a = 0; a < 2; ++a)
#pragma unroll
        for (int b = 0; b < 2; ++b)
#pragma unroll
            for (int m = 0; m < 4; ++m)
#pragma unroll
                for (int n = 0; n < 2; ++n) acc[a][b][m][n] = (f32x4){0.f, 0.f, 0.f, 0.f};
    bf16x8 At[4][2], B0[2][2], B1[2][2];
    i32x8 At8[4], B08[2], B18[2];
    const char* cA = S.aptr(cur); const char* cB = S.bptr(cur);
    S.a_ready(cur);
    if constexpr (SP2) {
        PG8_STAGE(PG8_SB(0, 0), cB, voffB); PG8_STAGE(PG8_SB(0, 1), cB + hstep, voffB); PG8_STAGE(PG8_SA(0, 0), cA, voffA); PG8_STAGE(PG8_SA(0, 1), cA + hstep, voffA);
        if (wr == 1) PG8_BAR;
        PG8_WAIT_V(2); PG8_BAR;
        PG8_STAGE(PG8_SB(1, 0), cB + kstep, voffB); PG8_STAGE(PG8_SA(1, 0), cA + kstep, voffA); PG8_STAGE(PG8_SB(1, 1), cB + hstep + kstep, voffB);
        PG8_WAIT_V(6); PG8_BAR;
    } else {
        PG8_STAGE(PG8_SB(0, 0), cB, voffB); PG8_STAGE(PG8_SA(0, 0), cA, voffA); PG8_STAGE(PG8_SB(0, 1), cB + hstep, voffB); PG8_STAGE(PG8_SA(0, 1), cA + hstep, voffA);
        if (wr == 1) PG8_BAR;
        PG8_WAIT_V(4); PG8_BAR;
        PG8_STAGE(PG8_SB(1, 0), cB + kstep, voffB); PG8_STAGE(PG8_SA(1, 0), cA + kstep, voffA); PG8_STAGE(PG8_SB(1, 1), cB + hstep + kstep, voffB);
        PG8_WAIT_V(6); PG8_BAR;
    }
    for (;;) {
        const bool has_next = S.next(ui + 1, nxt);
        const char* nA = has_next ? S.aptr(nxt) : cA; const char* nB = has_next ? S.bptr(nxt) : cB;
        for (int t = 0; t < nt; t += 2) {
            const bool last = (t == nt - 2);
            const char* a1 = cA + (size_t)(t + 1) * kstep;
            const char* a2 = last ? nA : cA + (size_t)(t + 2) * kstep; const char* b2 = last ? nB : cB + (size_t)(t + 2) * kstep;
            const char* a3 = a2 + kstep; const char* b3 = b2 + kstep;
            if (last && has_next) S.a_ready(nxt);
            if constexpr (SP2) {
            PG8_LDB(B0, 0, 0); PG8_LDB(B1, 0, 1); PG8_SCHED; PG8_LDA(At, 0, 0); PG8_STAGE(PG8_SA(1, 1), a1 + hstep, voffA);
            PG8_WAIT_V(8); PG8_WAIT_L(0); PG8_BAR; PG8_MMA(0, 0, At, B0); PG8_MMA(0, 1, At, B1); PG8_BAR; PG8_SCHED;
            PG8_LDA(At, 0, 1); PG8_STAGE(PG8_SB(0, 0), b2, voffB); PG8_STAGE(PG8_SB(0, 1), b2 + hstep, voffB); PG8_STAGE(PG8_SA(0, 0), a2, voffA);
            PG8_WAIT_V(8); PG8_WAIT_L(0); PG8_BAR; PG8_MMA(1, 0, At, B0); PG8_MMA(1, 1, At, B1); PG8_BAR; PG8_SCHED;
            PG8_LDB(B0, 1, 0); PG8_LDB(B1, 1, 1); PG8_SCHED; PG8_LDA(At, 1, 0); PG8_STAGE(PG8_SA(0, 1), a2 + hstep, voffA);
            PG8_WAIT_V(8); PG8_WAIT_L(0); PG8_BAR; PG8_MMA(0, 0, At, B0); PG8_MMA(0, 1, At, B1); PG8_BAR; PG8_SCHED;
            PG8_LDA(At, 1, 1); PG8_STAGE(PG8_SB(1, 0), b3, voffB); PG8_STAGE(PG8_SB(1, 1), b3 + hstep, voffB); PG8_STAGE(PG8_SA(1, 0), a3, voffA);
            PG8_WAIT_V(8); PG8_WAIT_L(0); PG8_BAR; PG8_MMA(1, 0, At, B0); PG8_MMA(1, 1, At, B1); PG8_BAR; PG8_SCHED;
            } else {
            PG8_LDB(B0, 0, 0); PG8_SCHED; PG8_LDA(At, 0, 0); PG8_STAGE(PG8_SA(1, 1), a1 + hstep, voffA);
            PG8_WAIT_L(8); PG8_BAR; PG8_WAIT_L(0); PG8_MMA(0, 0, At, B0); PG8_BAR; PG8_SCHED;
            PG8_LDB(B1, 0, 1); PG8_STAGE(PG8_SB(0, 0), b2, voffB);
            PG8_BAR; PG8_WAIT_L(0); PG8_MMA(0, 1, At, B1); PG8_BAR;
            PG8_LDA(At, 0, 1); PG8_STAGE(PG8_SA(0, 0), a2, voffA);
            PG8_BAR; PG8_WAIT_L(0); PG8_MMA(1, 0, At, B0); PG8_BAR; PG8_SCHED;
            PG8_STAGE(PG8_SB(0, 1), b2 + hstep, voffB);
            PG8_WAIT_V(6); PG8_BAR; PG8_MMA(1, 1, At, B1); PG8_BAR;
            PG8_LDB(B0, 1, 0); PG8_SCHED; PG8_LDA(At, 1, 0); PG8_STAGE(PG8_SA(0, 1), a2 + hstep, voffA);
            PG8_WAIT_L(8); PG8_BAR; PG8_WAIT_L(0); PG8_MMA(0, 0, At, B0); PG8_BAR; PG8_SCHED;
            PG8_LDB(B1, 1, 1); PG8_STAGE(PG8_SB(1, 0), b3, voffB);
            PG8_BAR; PG8_WAIT_L(0); PG8_MMA(0, 1, At, B1); PG8_BAR;
            PG8_LDA(At, 1, 1); PG8_STAGE(PG8_SA(1, 0), a3, voffA);
            PG8_BAR; PG8_WAIT_L(0); PG8_MMA(1, 0, At, B0); PG8_BAR; PG8_SCHED;
            PG8_STAGE(PG8_SB(1, 1), b3 + hstep, voffB);
            PG8_WAIT_V(6); PG8_BAR; PG8_MMA(1, 1, At, B1); PG8_BAR;
            }
        }
        if constexpr (ALIGN_EPI) { if (wr == 0) PG8_BAR; }
        if constexpr (F8) {
#define PG8_PIN8(a, b) asm volatile("s_nop 15\n\ts_nop 15" : "+v"(acc[a][b][0][0]), "+v"(acc[a][b][0][1]), "+v"(acc[a][b][1][0]), "+v"(acc[a][b][1][1]), "+v"(acc[a][b][2][0]), "+v"(acc[a][b][2][1]), "+v"(acc[a][b][3][0]), "+v"(acc[a][b][3][1]))
            asm volatile("s_nop 15\n\ts_nop 15" ::: "memory"); PG8_PIN8(0, 0); PG8_PIN8(0, 1); PG8_PIN8(1, 0); PG8_PIN8(1, 1);
#undef PG8_PIN8
        }
        if constexpr (!Epi::AFTER_DRAIN) { E(acc, cur, wr, wc, fr, fq); S.done(cur); }
        if (!has_next) break;
#pragma unroll
        for (int a = 0; a < 2; ++a)
#pragma unroll
            for (int b = 0; b < 2; ++b)
#pragma unroll
                for (int m = 0; m < 4; ++m)
#pragma unroll
                    for (int n = 0; n < 2; ++n) acc[a][b][m][n] = (f32x4){0.f, 0.f, 0.f, 0.f};
        cur = nxt; cA = nA; cB = nB; ++ui;
        if constexpr (ALIGN_EPI) { if (wr == 1) PG8_BAR; }
    }
    PG8_WAIT_V(0);
    if constexpr (!ALIGN_EPI) { if (wr == 0) PG8_BAR; }
    PG8_BAR;
    if constexpr (Epi::AFTER_DRAIN) { E.fused(acc, cur, wr, wc, fr, fq, lds, wid, lane); S.done(cur); }
#undef PG8_SA
#undef PG8_SB
#undef PG8_STAGE
#undef PG8_LDA
#undef PG8_LD32
#undef PG8_LDB
#undef PG8_MMA
#undef PG8_WAIT_V
#undef PG8_WAIT_L
#undef PG8_BAR
#undef PG8_SCHED
}
}
#define XB_TMO      128
#define XB_XCNT(j)  (256  + 64 * (j))
#define XB_XSUB(j)  (1280 + 64 * (j))
#define XB_XGEN(j)  (2304 + 64 * (j))
#define XB_TOP      3328
#define XB_TOPGEN   3392
#define XCD_BAR_WORDS 3456
#define XB_SPIN_CAP (1u << 18)

__device__ __forceinline__ unsigned xb_ld(unsigned* p)              { return __hip_atomic_load(p, __ATOMIC_RELAXED, __HIP_MEMORY_SCOPE_AGENT); }
__device__ __forceinline__ unsigned xb_add(unsigned* p, unsigned v) { return __hip_atomic_fetch_add(p, v, __ATOMIC_RELAXED, __HIP_MEMORY_SCOPE_AGENT); }
__device__ __forceinline__ unsigned xb_xcc_id() { return (unsigned)__builtin_amdgcn_s_getreg((3 << 11) | 20) & 0xFu; }
#define XB_SPIN(cond, bar) do { unsigned _sp = 0; while (cond) { __builtin_amdgcn_s_sleep(1); \
    if ((++_sp & 255u) == 0u) { if (xb_ld(&(bar)[XB_TMO])) break; if (_sp > XB_SPIN_CAP) { atomicAdd(&(bar)[XB_TMO], 1u); break; } } } } while (0)

struct XcdBarrier {
    unsigned* bar; unsigned x;
    volatile LAS unsigned* st;
};

__device__ __forceinline__ XcdBarrier xcd_barrier_post(unsigned* bar, volatile LAS unsigned* st) {
    XcdBarrier b; b.bar = bar; b.x = xb_xcc_id(); b.st = st;
    if (threadIdx.x == 0) (void)xb_add(&bar[XB_XCNT(b.x)], 1u);
    return b;
}
__device__ __forceinline__ void xcd_barrier_complete(unsigned* bar, unsigned x, unsigned& nloc, unsigned& nx) {
    const unsigned G = gridDim.x * gridDim.y * gridDim.z;
    unsigned sum, cnt, mine, sp = 0u;
    for (;;) {
        sum = 0u; cnt = 0u; mine = 0u;
#pragma unroll
        for (unsigned j = 0; j < 16; ++j) { const unsigned c = xb_ld(&bar[XB_XCNT(j)]); sum += c; cnt += (c > 0u) ? 1u : 0u; mine = (j == x) ? c : mine; }
        if (sum == G) break;
        __builtin_amdgcn_s_sleep(1);
        if ((++sp & 255u) == 0u) { if (xb_ld(&bar[XB_TMO])) break; if (sp > XB_SPIN_CAP) { atomicAdd(&bar[XB_TMO], 1u); break; } }
    }
    nloc = mine > 0u ? mine : 1u; nx = cnt > 0u ? cnt : 1u;
}

__device__ __forceinline__ void xcd_barrier(const XcdBarrier& b) {
    asm volatile("s_waitcnt vmcnt(0)" ::: "memory");
    __syncthreads();
    if (threadIdx.x == 0) {
        unsigned* bar = b.bar;
        __builtin_amdgcn_s_waitcnt(0);
        unsigned nloc = b.st[0], nx = b.st[1];
        if (nloc == 0u) { xcd_barrier_complete(bar, b.x, nloc, nx); b.st[0] = nloc; b.st[1] = nx; }
        const unsigned old = xb_add(&bar[XB_XSUB(b.x)], 1u);
        const unsigned gen = old / nloc;
        if (old + 1u == (gen + 1u) * nloc) {
            __builtin_amdgcn_fence(__ATOMIC_RELEASE, "agent");
            asm volatile("s_waitcnt vmcnt(0)" ::: "memory");
            const unsigned og = xb_add(&bar[XB_TOP], 1u);
            const unsigned tg = og / nx;
            if (og + 1u == (tg + 1u) * nx) xb_add(&bar[XB_TOPGEN], 1u);
            else XB_SPIN(xb_ld(&bar[XB_TOPGEN]) == tg, bar);
            __builtin_amdgcn_fence(__ATOMIC_ACQUIRE, "agent");
            xb_add(&bar[XB_XGEN(b.x)], 1u);
            asm volatile("s_waitcnt vmcnt(0)" ::: "memory");
        } else {
            XB_SPIN(xb_ld(&bar[XB_XGEN(b.x)]) == gen, bar);
            __builtin_amdgcn_fence(__ATOMIC_ACQUIRE, "agent");
            asm volatile("s_waitcnt vmcnt(0)" ::: "memory");
        }
    }
    __syncthreads();
}

struct Frame {
    LAS unsigned char* lds;
    gu32* ctl;
    unsigned char* ws;
    int tid, lane, wave, vcu, G;
    const float* const* in;
    float* out;
};
enum { I_X = 0, I_MEM, I_LN1G, I_LN2G, I_MEMNG, I_WOUT, I_WKV, I_MQNG, I_MKNG, I_DAWIN, I_DAQNG, I_DAKNG, I_LQ1, I_LK1, I_LQ2, I_LK2, I_SUBG,
       I_SSMWIN, I_CONVW, I_CONVB, I_DTBIAS, I_ALOG, I_SSMD, I_SSMNG, I_FFNG, I_FFNU, I_FFND, I_ROUTER, I_MOEG, I_MOEU, I_MOED, N_IN };

__device__ __forceinline__ void cvt_item(const float* W, int ldw, int k0, int n0, int nvalid, bf16_t* WT, int K, int drow0, LAS float* scr, int lane) {
    const int c = lane & 31;
#pragma unroll 8
    for (int i = 0; i < 32; ++i) { const int kk = 2 * i + (lane >> 5); float v = 0.f; if (c < nvalid) v = W[(size_t)(k0 + kk) * ldw + n0 + c]; scr[kk * 33 + c] = v; }
    LDS_WAIT(); asm volatile("" ::: "memory");
    const int c8 = lane & 7;
#pragma unroll
    for (int j = 0; j < 4; ++j) { const int n = (lane >> 3) + 8 * j; const LAS float* s = scr + (8 * c8) * 33 + n;
        u32x4 o; o.x = cvtpk(s[0 * 33], s[1 * 33]); o.y = cvtpk(s[2 * 33], s[3 * 33]); o.z = cvtpk(s[4 * 33], s[5 * 33]); o.w = cvtpk(s[6 * 33], s[7 * 33]);
        *(GAS u32x4*)(WT + (size_t)(drow0 + n) * K + k0 + 8 * c8) = o; }
    LDS_WAIT(); asm volatile("" ::: "memory");
}
__device__ __forceinline__ void cvt_item8(const float* W, int ldw, int k0, int n0, unsigned char* WT, int K, int drow0, LAS float* scr, int lane, float scale) {
    const int c = lane & 31;
#pragma unroll 8
    for (int i = 0; i < 32; ++i) { const int kk = 2 * i + (lane >> 5); scr[kk * 33 + c] = W[(size_t)(k0 + kk) * ldw + n0 + c]; }
    LDS_WAIT(); asm volatile("" ::: "memory");
    const int c8 = lane & 7;
#pragma unroll
    for (int j = 0; j < 4; ++j) { const int n = (lane >> 3) + 8 * j; const LAS float* s = scr + (8 * c8) * 33 + n;
        u32x2 o; o.x = pack4_fp8(s[0 * 33] * scale, s[1 * 33] * scale, s[2 * 33] * scale, s[3 * 33] * scale); o.y = pack4_fp8(s[4 * 33] * scale, s[5 * 33] * scale, s[6 * 33] * scale, s[7 * 33] * scale);
        *(GAS u32x2*)(WT + (size_t)(drow0 + n) * K + k0 + 8 * c8) = o; }
    LDS_WAIT(); asm volatile("" ::: "memory");
}
constexpr float W8_SCALE = 64.0f, ACT8_SCALE = 8.0f;
__device__ __forceinline__ void cvt_moe_gu8_item(const float* gate, const float* up, unsigned char* dst, int r, LAS float* scr, int lane) {
    constexpr int ngroups = NEXP * 2 * EXD / 32, gpe = 2 * EXD / 32;
    const int kb = r / ngroups, gi = r - kb * ngroups, e = gi / gpe, g2 = gi - e * gpe, j = g2 >> 3, gg = g2 & 7, bj = gg >> 2, wc = gg & 3;
    cvt_item8((bj ? up : gate) + (size_t)e * DM * EXD, EXD, kb * 64, 128 * j + 32 * wc, dst, DM, e * 2 * EXD + 32 * g2, scr, lane, W8_SCALE);
}
__device__ __forceinline__ void cvt_moe_dn8_item(const float* down, unsigned char* dst, int r, LAS float* scr, int lane) {
    constexpr int ngroups = NEXP * DM / 32, gpe = DM / 32;
    const int kb = r / ngroups, gi = r - kb * ngroups, e = gi / gpe, g2 = gi - e * gpe;
    cvt_item8(down + (size_t)e * EXD * DM, DM, kb * 64, 32 * g2, dst, EXD, e * DM + 32 * g2, scr, lane, W8_SCALE);
}
enum { CK_PLAIN = 0, CK_HPERM = 1, CK_SSM = 2, CK_GU = 3, CK_PLAIN_E = 4 };
template <int KIND>
__device__ __forceinline__ void cvt_job_item(const float* src0, const float* src1, int ldw, int K, int ngroups, int F, bf16_t* dst, int r, LAS float* scr, int lane) {
    const int kb = r / ngroups, gi = r - kb * ngroups, k0 = kb * 64;
    if (KIND == CK_PLAIN) { cvt_item(src0, ldw, k0, 32 * gi, 32, dst, K, 32 * gi, scr, lane); }
    else if (KIND == CK_HPERM) { const int pn = gi >> 3, gg = gi & 7, bj = gg >> 2, wc = gg & 3; cvt_item(src0, ldw, k0, 256 * pn + 64 * wc + 32 * bj, 32, dst, K, 32 * gi, scr, lane); }
    else if (KIND == CK_SSM) { const int pn = gi >> 3, gg = gi & 7, bj = gg >> 2, wc = gg & 3, s0 = 64 * wc + 32 * bj; int n0, nv;
        if (pn < 8) { n0 = 256 * pn + s0; nv = 32; } else if (pn == 8) { n0 = 2060 + s0; nv = 32; } else { n0 = 2048 + s0; nv = (s0 == 0) ? 12 : 0; if (nv == 0) n0 = 0; }
        cvt_item(src0, ldw, k0, n0, nv, dst, K, 32 * gi, scr, lane); }
    else if (KIND == CK_GU) { const int gpe = 2 * F / 32, e = gi / gpe, g2 = gi - e * gpe, j = g2 >> 3, gg = g2 & 7, bj = gg >> 2, wc = gg & 3;
        const float* s = (bj ? src1 : src0) + (size_t)e * K * F; cvt_item(s, F, k0, 128 * j + 32 * wc, 32, dst, K, e * 2 * F + 32 * g2, scr, lane); }
    else { const int gpe = F / 32, e = gi / gpe, g2 = gi - e * gpe;
        cvt_item(src0 + (size_t)e * K * F, F, k0, 32 * g2, 32, dst, K, e * F + 32 * g2, scr, lane); }
}

__device__ __forceinline__ void rms_row_bf16(const float* xrow, const float* g, bf16_t* orow, int lane) {
    const GAS f32x4* xr = (const GAS f32x4*)xrow + lane; const GAS f32x4* gr = (const GAS f32x4*)g + lane;
    f32x4 v[4]; float s = 0.f;
#pragma unroll
    for (int j = 0; j < 4; ++j) { v[j] = xr[64 * j]; s += (v[j].x * v[j].x + v[j].y * v[j].y) + (v[j].z * v[j].z + v[j].w * v[j].w); }
    const float rstd = 1.0f / sqrtf(wave_sum(s) * (1.f / DM) + EPS);
    GAS u32x2* o8 = (GAS u32x2*)orow + lane;
#pragma unroll
    for (int j = 0; j < 4; ++j) { const f32x4 gg = gr[64 * j]; u32x2 w; w.x = cvtpk(v[j].x * rstd * gg.x, v[j].y * rstd * gg.y); w.y = cvtpk(v[j].z * rstd * gg.z, v[j].w * rstd * gg.w); o8[64 * j] = w; }
}

__device__ __forceinline__ void phase_prologue(Frame& F) {
    LAS float* scr = (LAS float*)(F.lds + F.wave * 16384);
    const int gw = F.vcu * NWAVES + F.wave, NGW = F.G * NWAVES;
    const float* const* in = F.in;
    unsigned char* ws = F.ws;
    constexpr int J1 = 16 * 80, J2 = 16 * 32, J3 = 16 * 32, J4 = 16 * 16, J5 = 16 * 16, J6 = 16 * 80, J7 = 16 * 176, J8 = 44 * 32, J9 = 16 * 1792, J10 = 56 * 256;
    constexpr int TOTAL = J1 + J2 + J3 + J4 + J5 + J6 + J7 + J8 + J9 + J10;
    for (int it = gw; it < TOTAL; it += NGW) {
        int r = it;
        if (r < J9) { cvt_moe_gu8_item(in[I_MOEG], in[I_MOEU], ws + WS_WMGU, r, scr, F.lane); continue; } r -= J9;
        if (r < J10) { cvt_moe_dn8_item(in[I_MOED], ws + WS_WMDN, r, scr, F.lane); continue; } r -= J10;
        if (r < J7) { cvt_job_item<CK_GU>(in[I_FFNG], in[I_FFNU], FFN, DM, 176, FFN, (bf16_t*)(ws + WS_WGU), r, scr, F.lane); continue; } r -= J7;
        if (r < J8) { cvt_job_item<CK_PLAIN>(in[I_FFND], nullptr, DM, FFN, 32, 0, (bf16_t*)(ws + WS_WDN), r, scr, F.lane); continue; } r -= J8;
        if (r < J1) { cvt_job_item<CK_HPERM>(in[I_DAWIN], nullptr, NPROJ, DM, 80, 0, (bf16_t*)(ws + WS_WDA), r, scr, F.lane); continue; } r -= J1;
        if (r < J6) { cvt_job_item<CK_SSM>(in[I_SSMWIN], nullptr, SSM_IN, DM, 80, 0, (bf16_t*)(ws + WS_WSSM), r, scr, F.lane); continue; } r -= J6;
        if (r < J2) { cvt_job_item<CK_PLAIN>(in[I_WOUT], nullptr, DM, DM, 32, 0, (bf16_t*)(ws + WS_WOUT0), r, scr, F.lane); continue; } r -= J2;
        if (r < J3) { cvt_job_item<CK_PLAIN>(in[I_WOUT] + (size_t)DM * DM, nullptr, DM, DM, 32, 0, (bf16_t*)(ws + WS_WOUT1), r, scr, F.lane); continue; } r -= J3;
        if (r < J4) { cvt_job_item<CK_HPERM>(in[I_WKV], nullptr, 512, DM, 16, 0, (bf16_t*)(ws + WS_WKV0), r, scr, F.lane); continue; } r -= J4;
        cvt_job_item<CK_HPERM>(in[I_WKV] + (size_t)DM * 512, nullptr, 512, DM, 16, 0, (bf16_t*)(ws + WS_WKV1), r, scr, F.lane);
    }
    for (int m = gw; m < MEMROWS; m += NGW) rms_row_bf16(in[I_MEM] + (size_t)m * DM, in[I_MEMNG], (bf16_t*)(ws + WS_MEMN) + (size_t)m * DM, F.lane);
    for (int m = gw; m < T; m += NGW) rms_row_bf16(in[I_X] + (size_t)m * DM, in[I_LN1G], (bf16_t*)(ws + WS_XN) + (size_t)m * DM, F.lane);
#if MK_LEVEL == 0
    for (int m = gw; m < T; m += NGW) { const GAS f32x4* xr = (const GAS f32x4*)(in[I_X] + (size_t)m * DM) + F.lane; GAS f32x4* o = (GAS f32x4*)(F.out + (size_t)m * DM) + F.lane;
#pragma unroll
        for (int j = 0; j < 4; ++j) o[64 * j] = xr[64 * j]; }
#endif
}
__device__ __forceinline__ void phase_rownorm(Frame& F, const float* g, bf16_t* dst) {
    const int gw = F.vcu * NWAVES + F.wave, NGW = F.G * NWAVES;
    for (int m = gw; m < T; m += NGW) rms_row_bf16(F.out + (size_t)m * DM, g, dst + (size_t)m * DM, F.lane);
}

struct SchedPlain : pg8::StaticOrder {
    const char* A; const char* B; size_t ta, tb;
    __device__ __forceinline__ const char* aptr(const pg8::Unit& u) const { return A + (size_t)u.pm * ta; }
    __device__ __forceinline__ const char* bptr(const pg8::Unit& u) const { return B + (size_t)u.pn * tb; }
};
struct SchedP1 {
    pg8::StaticOrder so; const char* ws;
    __device__ __forceinline__ bool next(int i, pg8::Unit& u) const {
        if (so.next(i, u)) { u.aux = 0; return true; }
        const long L = (long)i * so.G + so.c - so.nwg; if (L >= 16) return false;
        const int r = (int)L; u.aux = 1 + (r >> 3); u.pm = (r & 7) >> 1; u.pn = r & 1; return true;
    }
    __device__ __forceinline__ const char* aptr(const pg8::Unit& u) const { const size_t o = (u.aux == 0) ? WS_XN : WS_MEMN; return ws + o + (size_t)u.pm * (256 * DM * 2); }
    __device__ __forceinline__ const char* bptr(const pg8::Unit& u) const { const size_t o = (u.aux == 0) ? WS_WDA : (u.aux == 1 ? WS_WKV0 : WS_WKV1); return ws + o + (size_t)u.pn * (256 * DM * 2); }
    __device__ __forceinline__ void a_ready(const pg8::Unit&) const {}
    __device__ __forceinline__ void done(const pg8::Unit&) const {}
};
struct SchedMoe : pg8::StaticOrder {
    const char* A; const char* B; size_t ta, tb, eb; const int* tile_e;
    __device__ __forceinline__ bool next(int i, pg8::Unit& u) const { if (!pg8::StaticOrder::next(i, u)) return false; u.aux = tile_e[u.pm]; return true; }
    __device__ __forceinline__ const char* aptr(const pg8::Unit& u) const { return A + (size_t)u.pm * ta; }
    __device__ __forceinline__ const char* bptr(const pg8::Unit& u) const { return B + (size_t)u.aux * eb + (size_t)u.pn * tb; }
};

struct TileCfg { bf16_t* out; int ldc; int col0; int mode; int gain_off; float scale; float* dt; };
template <class CfgF> struct EpiProj {
    static constexpr bool PERM = true, AFTER_DRAIN = false;
    CfgF cf; LAS unsigned char* lds;
    __device__ __forceinline__ void operator()(const f32x4 (&acc)[2][2][4][2], const pg8::Unit& u, int wr, int wc, int fr, int fq) const {
        asm volatile("" : "+v"(fr), "+v"(fq));
        const TileCfg c = cf(u);
        const int row0 = u.pm * 256 + wr * 64 + fr;
        if (c.mode == 2) {
            if (wc == 0 && fq < 2) {
#pragma unroll
                for (int ai = 0; ai < 2; ++ai)
#pragma unroll
                    for (int m = 0; m < 4; ++m) { float* p = c.dt + (size_t)(row0 + ai * 128 + m * 16) * 16 + fq * 8; *(f32x4*)p = acc[ai][0][m][0]; *(f32x4*)(p + 4) = acc[ai][0][m][1]; }
            }
            return;
        }
        f32x4 gv[2][2];
#pragma unroll
        for (int bj = 0; bj < 2; ++bj)
#pragma unroll
            for (int n = 0; n < 2; ++n) gv[bj][n] = (c.mode == 1) ? *(const LAS f32x4*)(lds + c.gain_off + (32 * bj + 8 * fq + 4 * n) * 4) : (f32x4){1.f, 1.f, 1.f, 1.f};
#pragma unroll
        for (int ai = 0; ai < 2; ++ai)
#pragma unroll
            for (int m = 0; m < 4; ++m) {
                float rs = 1.0f;
                if (c.mode == 1) {
                    float ss = 0.f;
#pragma unroll
                    for (int bj = 0; bj < 2; ++bj)
#pragma unroll
                        for (int n = 0; n < 2; ++n) { const f32x4 v = acc[ai][bj][m][n]; ss += (v.x * v.x + v.y * v.y) + (v.z * v.z + v.w * v.w); }
                    ss += __shfl_xor(ss, 16); ss += __shfl_xor(ss, 32);
                    rs = c.scale / sqrtf(ss * (1.0f / 64.0f) + EPS);
                }
                bf16_t* rowp = c.out + (size_t)(row0 + ai * 128 + m * 16) * c.ldc + c.col0 + 64 * wc + 8 * fq;
#pragma unroll
                for (int bj = 0; bj < 2; ++bj) { const f32x4 v0 = acc[ai][bj][m][0] * gv[bj][0] * rs, v1 = acc[ai][bj][m][1] * gv[bj][1] * rs;
                    u32x4 w; w.x = cvtpk(v0.x, v0.y); w.y = cvtpk(v0.z, v0.w); w.z = cvtpk(v1.x, v1.y); w.w = cvtpk(v1.z, v1.w);
                    *(u32x4*)(rowp + 32 * bj) = w; }
            }
    }
};
template <bool OUT8> struct EpiSwiGLU {
    static constexpr bool PERM = true, AFTER_DRAIN = false;
    void* O; int ldc; float sin, sout;
    __device__ __forceinline__ void operator()(const f32x4 (&acc)[2][2][4][2], const pg8::Unit& u, int wr, int wc, int fr, int fq) const {
        asm volatile("" : "+v"(fr), "+v"(fq));
        const int row0 = u.pm * 256 + wr * 64 + fr, col0 = u.pn * 128 + wc * 32 + 8 * fq;
#pragma unroll
        for (int ai = 0; ai < 2; ++ai)
#pragma unroll
            for (int m = 0; m < 4; ++m) { f32x4 g0 = acc[ai][0][m][0], g1 = acc[ai][0][m][1], u0 = acc[ai][1][m][0], u1 = acc[ai][1][m][1];
                const size_t off = (size_t)(row0 + ai * 128 + m * 16) * ldc + col0;
                if (OUT8) { g0 = g0 * sin; g1 = g1 * sin; u0 = u0 * (sin * sout); u1 = u1 * (sin * sout);
                    u32x2 w; w.x = pack4_fp8(silu_f(g0.x) * u0.x, silu_f(g0.y) * u0.y, silu_f(g0.z) * u0.z, silu_f(g0.w) * u0.w);
                    w.y = pack4_fp8(silu_f(g1.x) * u1.x, silu_f(g1.y) * u1.y, silu_f(g1.z) * u1.z, silu_f(g1.w) * u1.w);
                    *(u32x2*)((unsigned char*)O + off) = w; }
                else { u32x4 w; w.x = cvtpk(silu_f(g0.x) * u0.x, silu_f(g0.y) * u0.y); w.y = cvtpk(silu_f(g0.z) * u0.z, silu_f(g0.w) * u0.w);
                    w.z = cvtpk(silu_f(g1.x) * u1.x, silu_f(g1.y) * u1.y); w.w = cvtpk(silu_f(g1.z) * u1.z, silu_f(g1.w) * u1.w);
                    *(u32x4*)((bf16_t*)O + off) = w; } }
    }
};
struct EpiResid {
    static constexpr bool PERM = false, AFTER_DRAIN = false;
    const float* base; float* out;
    __device__ __forceinline__ void operator()(const f32x4 (&acc)[2][2][4][2], const pg8::Unit& u, int wr, int wc, int fr, int fq) const {
        asm volatile("" : "+v"(fr), "+v"(fq));
        const int row0 = u.pm * 256 + wr * 64 + fr, col0 = u.pn * 256 + wc * 32 + 4 * fq;
#pragma unroll
        for (int ai = 0; ai < 2; ++ai)
#pragma unroll
            for (int m = 0; m < 4; ++m) { const size_t off = (size_t)(row0 + ai * 128 + m * 16) * DM + col0;
#pragma unroll
                for (int bj = 0; bj < 2; ++bj)
#pragma unroll
                    for (int n = 0; n < 2; ++n) { const f32x4 b = *(const f32x4*)(base + off + bj * 128 + n * 16); *(f32x4*)(out + off + bj * 128 + n * 16) = b + acc[ai][bj][m][n]; } }
    }
};
struct EpiBf16 {
    static constexpr bool PERM = true, AFTER_DRAIN = false;
    bf16_t* O; int ldc; float sc;
    __device__ __forceinline__ void operator()(const f32x4 (&acc)[2][2][4][2], const pg8::Unit& u, int wr, int wc, int fr, int fq) const {
        asm volatile("" : "+v"(fr), "+v"(fq));
        const int row0 = u.pm * 256 + wr * 64 + fr, col0 = u.pn * 256 + wc * 32 + 8 * fq;
#pragma unroll
        for (int ai = 0; ai < 2; ++ai)
#pragma unroll
            for (int m = 0; m < 4; ++m) { bf16_t* rowp = O + (size_t)(row0 + ai * 128 + m * 16) * ldc + col0;
#pragma unroll
                for (int bj = 0; bj < 2; ++bj) { const f32x4 v0 = acc[ai][bj][m][0] * sc, v1 = acc[ai][bj][m][1] * sc;
                    u32x4 w; w.x = cvtpk(v0.x, v0.y); w.y = cvtpk(v0.z, v0.w); w.z = cvtpk(v1.x, v1.y); w.w = cvtpk(v1.z, v1.w);
                    *(u32x4*)(rowp + bj * 128) = w; } }
    }
};

constexpr int LC_QG = CONST_OFF + 0, LC_KG = CONST_OFF + 256, LC_MQG = CONST_OFF + 512, LC_MKG0 = CONST_OFF + 768, LC_MKG1 = CONST_OFF + 1024;
constexpr int LC_SCAL = CONST_OFF + 1280;
constexpr int LC_SUBG = CONST_OFF + 1536;
constexpr int LC_QIDX = MISC_OFF + 64;

struct CfgP1 { bf16_t* U; bf16_t* KVM;
    __device__ __forceinline__ TileCfg operator()(const pg8::Unit& u) const { TileCfg c; c.dt = nullptr;
        if (u.aux == 0) { c.out = U; c.ldc = NPROJ; c.col0 = 256 * u.pn;
            if (u.pn < 3) { c.mode = 1; c.gain_off = LC_QG; c.scale = 0.125f * LOG2E; }
            else if (u.pn < 6) { c.mode = 1; c.gain_off = LC_KG; c.scale = 1.0f; }
            else if (u.pn < 9) { c.mode = 0; c.gain_off = LC_QG; c.scale = 1.0f; }
            else { c.mode = 1; c.gain_off = LC_MQG; c.scale = 0.125f * LOG2E; } }
        else { c.out = KVM + (size_t)(u.aux - 1) * MEMROWS * 512; c.ldc = 512; c.col0 = 256 * u.pn; c.scale = 1.0f; c.gain_off = (u.aux == 1) ? LC_MKG0 : LC_MKG1; c.mode = (u.pn == 0) ? 1 : 0; }
        return c; } };
struct CfgP8 { bf16_t* U; float* DT;
    __device__ __forceinline__ TileCfg operator()(const pg8::Unit& u) const { TileCfg c; c.out = U; c.ldc = NPROJ; c.col0 = 256 * u.pn; c.dt = DT; c.gain_off = LC_MQG; c.scale = 1.0f; c.mode = 0;
        if (u.pn == 8) { c.mode = 1; c.scale = 0.125f * LOG2E; } else if (u.pn == 9) c.mode = 2;
        return c; } };

__device__ __forceinline__ void lds_load_vec64(Frame& F, int off, const float* src) { if (F.tid < 64) *(LAS float*)(F.lds + off + F.tid * 4) = src[F.tid]; }

constexpr int AT_K = 0, AT_V = 32768, AT_X = 65536;

__device__ __forceinline__ void diff_attn_unit(Frame& F, int b, int h, int j, const bf16_t* U, bf16_t* MIX) {
    LAS unsigned char* lds = F.lds;
    const int lane = F.lane, r32 = lane & 31, hi = lane >> 5, w = F.wave, map = w & 1, qsub = w >> 1;
    const size_t rowbase = (size_t)b * SEQ; const int q0 = j * 128;
    const float shift = *(const LAS float*)(lds + LC_SCAL), lam = *(const LAS float*)(lds + LC_SCAL + 4);
    const bf16_t* Qw = U + (rowbase + q0 + qsub * 32 + r32) * NPROJ + h * 128 + map * 64 + hi * 8;
    bf16x8 qr[4];
#pragma unroll
    for (int d0 = 0; d0 < 4; ++d0) qr[d0] = *(const bf16x8*)(Qw + d0 * 16);
    const int NT = 2 * j + 2, myNT = 2 * j + 1 + (qsub >> 1);
    const bf16_t* ksrc = U + (rowbase + lane) * NPROJ + 768 + h * 128 + w * 8;
    const bf16_t* vsrc = U + (rowbase + 16 * (w & 3) + (lane >> 2)) * NPROJ + 1536 + h * 128 + (w >> 2) * 32 + (lane & 3) * 8;
    const unsigned lds0 = (unsigned)(uintptr_t)lds;
#define AT_DMA(t, slot) do { const size_t o_ = (size_t)(t) * 64 * NPROJ; \
        glds16(ksrc + o_, (unsigned)__builtin_amdgcn_readfirstlane(lds0 + AT_K + (slot) * 16384 + w * 1024)); \
        glds16(ksrc + o_ + 64, (unsigned)__builtin_amdgcn_readfirstlane(lds0 + AT_K + (slot) * 16384 + 8192 + w * 1024)); \
        glds16(vsrc + o_, (unsigned)__builtin_amdgcn_readfirstlane(lds0 + AT_V + (slot) * 16384 + w * 1024)); \
        glds16(vsrc + o_ + 64, (unsigned)__builtin_amdgcn_readfirstlane(lds0 + AT_V + (slot) * 16384 + 8192 + w * 1024)); } while (0)
    AT_DMA(0, 0);
    f32x16 oT[4]; float lsum = 0.f;
#pragma unroll
    for (int i = 0; i < 4; ++i) oT[i] = (f32x16){};
    f32x16 negs;
#pragma unroll
    for (int r = 0; r < 16; ++r) negs[r] = -shift;
    for (int t = 0; t < NT; ++t) {
        WG_BAR();
        const int slot = t & 1;
        if (t + 1 < NT) AT_DMA(t + 1, slot ^ 1);
        if (t < myNT) {
            const LAS unsigned char* kb = lds + AT_K + slot * 16384 + map * 8192 + hi * 1024 + r32 * 16;
            f32x16 s0 = negs, s1 = negs;
#pragma unroll
            for (int d0 = 0; d0 < 4; ++d0) { const bf16x8 a0 = *(const LAS bf16x8*)(kb + d0 * 2048), a1 = *(const LAS bf16x8*)(kb + d0 * 2048 + 512);
                s0 = MFMA32(a0, qr[d0], s0); s1 = MFMA32(a1, qr[d0], s1); }
#pragma unroll
            for (int r = 0; r < 16; ++r) { s0[r] = fast_exp2(s0[r]); s1[r] = fast_exp2(s1[r]); }
            float ps = 0.f;
#pragma unroll
            for (int r = 0; r < 16; ++r) ps += s0[r] + s1[r];
            lsum += ps;
            u32x4 pw[4];
#pragma unroll
            for (int q = 0; q < 4; ++q) { pw[0][q] = cvtpk(s0[2 * q], s0[2 * q + 1]); pw[1][q] = cvtpk(s0[8 + 2 * q], s0[8 + 2 * q + 1]);
                                          pw[2][q] = cvtpk(s1[2 * q], s1[2 * q + 1]); pw[3][q] = cvtpk(s1[8 + 2 * q], s1[8 + 2 * q + 1]); }
            const LAS unsigned char* vp = lds + AT_V + slot * 16384 + ((lane >> 4) & 1) * 32 + (lane & 3) * 8 + (4 * hi + ((lane & 15) >> 2)) * 64;
#pragma unroll
            for (int db = 0; db < 4; ++db)
#pragma unroll
                for (int ks = 0; ks < 4; ++ks) { const s16x4 lo = vtr(vp + db * 4096 + ks * 1024), hh = vtr(vp + db * 4096 + ks * 1024 + 512);
                    oT[db] = MFMA32(cat8(lo, hh), __builtin_bit_cast(bf16x8, pw[ks]), oT[db]); }
        }
    }
#undef AT_DMA
    lsum += __shfl_xor(lsum, 32);
    const float inv = 1.0f / lsum;
    LAS float* xch = (LAS float*)(lds + AT_X + qsub * 16384);
    if (map == 1) {
        const float f = lam * inv;
#pragma unroll
        for (int db = 0; db < 4; ++db)
#pragma unroll
            for (int r = 0; r < 16; ++r) xch[(db * 16 + r) * 64 + lane] = oT[db][r] * f;
    }
    WG_BAR();
    if (map == 0) {
        float ss = 0.f;
#pragma unroll
        for (int db = 0; db < 4; ++db)
#pragma unroll
            for (int r = 0; r < 16; ++r) { const float o = oT[db][r] * inv - xch[(db * 16 + r) * 64 + lane]; oT[db][r] = o; ss += o * o; }
        ss += __shfl_xor(ss, 32);
        const float rs = 0.8f / sqrtf(ss * (1.0f / 128.0f) + EPS);
        bf16_t* orow = MIX + (rowbase + q0 + qsub * 32 + r32) * DM + h * 128;
        const LAS float* sg = (const LAS float*)(lds + LC_SUBG);
#pragma unroll
        for (int db = 0; db < 4; ++db)
#pragma unroll
            for (int q = 0; q < 4; ++q) { const int d = 32 * db + 8 * q + 4 * hi; const f32x4 g = *(const LAS f32x4*)(sg + d);
                u32x2 wv; wv.x = cvtpk(oT[db][4 * q] * rs * g.x, oT[db][4 * q + 1] * rs * g.y); wv.y = cvtpk(oT[db][4 * q + 2] * rs * g.z, oT[db][4 * q + 3] * rs * g.w);
                *(u32x2*)(orow + d) = wv; }
    }
}

__device__ __forceinline__ void mem_attn_unit(Frame& F, int b, int mh, int qb, const bf16_t* U, int mqcol, const bf16_t* KVM, bf16_t* MIX) {
    LAS unsigned char* lds = F.lds;
    const int lane = F.lane, r32 = lane & 31, hi = lane >> 5, w = F.wave;
    const float shift = *(const LAS float*)(lds + LC_SCAL + 8);
    const size_t row = (size_t)b * SEQ + qb * 256 + w * 32 + r32;
    const bf16_t* Qw = U + row * NPROJ + mqcol + mh * 64 + hi * 8;
    bf16x8 qr[4];
#pragma unroll
    for (int d0 = 0; d0 < 4; ++d0) qr[d0] = *(const bf16x8*)(Qw + d0 * 16);
    const unsigned lds0 = (unsigned)(uintptr_t)lds;
    const bf16_t* ksrc = KVM + ((size_t)b * MEM_LEN + lane) * 512 + mh * 64 + w * 8;
    const bf16_t* vsrc = KVM + ((size_t)b * MEM_LEN + 16 * (w & 3) + (lane >> 2)) * 512 + 256 + mh * 64 + (w >> 2) * 32 + (lane & 3) * 8;
#pragma unroll
    for (int t = 0; t < 4; ++t) { glds16(ksrc + (size_t)t * 64 * 512, (unsigned)__builtin_amdgcn_readfirstlane(lds0 + t * 8192 + w * 1024));
                                  glds16(vsrc + (size_t)t * 64 * 512, (unsigned)__builtin_amdgcn_readfirstlane(lds0 + 32768 + t * 8192 + w * 1024)); }
    WG_BAR();
    f32x16 oT[2]; oT[0] = (f32x16){}; oT[1] = (f32x16){}; float lsum = 0.f;
    f32x16 negs;
#pragma unroll
    for (int r = 0; r < 16; ++r) negs[r] = -shift;
#pragma unroll 1
    for (int t = 0; t < 4; ++t) {
        const LAS unsigned char* kb = lds + t * 8192 + hi * 1024 + r32 * 16;
        f32x16 s0 = negs, s1 = negs;
#pragma unroll
        for (int d0 = 0; d0 < 4; ++d0) { const bf16x8 a0 = *(const LAS bf16x8*)(kb + d0 * 2048), a1 = *(const LAS bf16x8*)(kb + d0 * 2048 + 512);
            s0 = MFMA32(a0, qr[d0], s0); s1 = MFMA32(a1, qr[d0], s1); }
        float ps = 0.f;
#pragma unroll
        for (int r = 0; r < 16; ++r) { s0[r] = fast_exp2(s0[r]); s1[r] = fast_exp2(s1[r]); ps += s0[r] + s1[r]; }
        lsum += ps;
        u32x4 pw[4];
#pragma unroll
        for (int q = 0; q < 4; ++q) { pw[0][q] = cvtpk(s0[2 * q], s0[2 * q + 1]); pw[1][q] = cvtpk(s0[8 + 2 * q], s0[8 + 2 * q + 1]);
                                      pw[2][q] = cvtpk(s1[2 * q], s1[2 * q + 1]); pw[3][q] = cvtpk(s1[8 + 2 * q], s1[8 + 2 * q + 1]); }
        const LAS unsigned char* vp = lds + 32768 + t * 8192 + ((lane >> 4) & 1) * 32 + (lane & 3) * 8 + (4 * hi + ((lane & 15) >> 2)) * 64;
#pragma unroll
        for (int db = 0; db < 2; ++db)
#pragma unroll
            for (int ks = 0; ks < 4; ++ks) { const s16x4 lo = vtr(vp + db * 4096 + ks * 1024), hh = vtr(vp + db * 4096 + ks * 1024 + 512);
                oT[db] = MFMA32(cat8(lo, hh), __builtin_bit_cast(bf16x8, pw[ks]), oT[db]); }
    }
    lsum += __shfl_xor(lsum, 32);
    const float inv = 1.0f / lsum;
    bf16_t* orow = MIX + row * DM + TOK_W + mh * 64;
#pragma unroll
    for (int db = 0; db < 2; ++db)
#pragma unroll
        for (int q = 0; q < 4; ++q) { const int d = 32 * db + 8 * q + 4 * hi;
            u32x2 wv; wv.x = cvtpk(oT[db][4 * q] * inv, oT[db][4 * q + 1] * inv); wv.y = cvtpk(oT[db][4 * q + 2] * inv, oT[db][4 * q + 3] * inv);
            *(u32x2*)(orow + d) = wv; }
    WG_BAR();
}

__device__ __forceinline__ int queue_pop(Frame& F, gu32* head) {
    if (F.tid == 0) *(volatile LAS unsigned*)(F.lds + LC_QIDX) = __hip_atomic_fetch_add(head, 1u, RLX_AGENT);
    WG_BAR();
    const int v = (int)*(volatile LAS unsigned*)(F.lds + LC_QIDX);
    WG_BAR();
    return v;
}
__device__ __forceinline__ float max_abs64(const float* g, int lane) { float v = fabsf(g[lane]);
#pragma unroll
    for (int o = 1; o < 64; o <<= 1) v = fmaxf(v, __shfl_xor(v, o));
    return v; }
__device__ __forceinline__ void attn_consts(Frame& F, int layer) {
    const float* const* in = F.in;
    if (F.wave == 0) {
        const int l = F.lane;
        const float mq = max_abs64(in[I_DAQNG], l), mk = max_abs64(in[I_DAKNG], l);
        const float a = wave_sum(in[I_LQ1][l] * in[I_LK1][l]), c = wave_sum(in[I_LQ2][l] * in[I_LK2][l]);
        const float mmq = max_abs64(in[I_MQNG] + layer * 64, l), mmk = max_abs64(in[I_MKNG] + layer * 64, l);
        if (l == 0) { LAS float* s = (LAS float*)(F.lds + LC_SCAL); s[0] = 8.0f * mq * mk * LOG2E; s[1] = expf(a) - expf(c) + 0.2f; s[2] = 8.0f * mmq * mmk * LOG2E; }
        ((LAS float*)(F.lds + LC_SUBG))[l] = in[I_SUBG][l]; ((LAS float*)(F.lds + LC_SUBG))[64 + l] = in[I_SUBG][64 + l];
    }
    WG_BAR();
}
__device__ __forceinline__ void phase_attn0(Frame& F) {
    attn_consts(F, 0);
    const bf16_t* U = (const bf16_t*)(F.ws + WS_U); bf16_t* MIX = (bf16_t*)(F.ws + WS_MIX); const bf16_t* KVM = (const bf16_t*)(F.ws + WS_KVM);
    for (;;) {
        const int u = queue_pop(F, F.ctl + CW_Q0);
        if (u >= 768 + 256) break;
        if (u < 768) { const int j = 31 - u / 24, bh = u % 24; diff_attn_unit(F, bh / 6, bh % 6, j, U, MIX); }
        else { const int v = u - 768; mem_attn_unit(F, v >> 6, (v >> 4) & 3, v & 15, U, 2304, KVM, MIX); }
    }
}
__device__ __forceinline__ void phase_memattn1(Frame& F) {
    attn_consts(F, 1);
    const bf16_t* U = (const bf16_t*)(F.ws + WS_U); bf16_t* MIX = (bf16_t*)(F.ws + WS_MIX); const bf16_t* KVM = (const bf16_t*)(F.ws + WS_KVM) + (size_t)MEMROWS * 512;
    for (;;) {
        const int v = queue_pop(F, F.ctl + CW_Q1);
        if (v >= 256) break;
        mem_attn_unit(F, v >> 6, (v >> 4) & 3, v & 15, U, 2048, KVM, MIX);
    }
}

constexpr int LC_CUM = CONST_OFF + 2048, LC_DTS = CONST_OFF + 3584, LC_PART = CONST_OFF + 5120, LC_NG = CONST_OFF + 6144;
constexpr int S1_XS = 0, S1_BM = 49152, S1_TOEND = 65536;
__device__ __forceinline__ float softplus_f(float x) { return x > 20.0f ? x : log1pf(expf(x)); }

__device__ __forceinline__ void phase_ssd_local(Frame& F) {
    LAS unsigned char* lds = F.lds; const float* const* in = F.in;
    const bf16_t* U = (const bf16_t*)(F.ws + WS_U); bf16_t* CONV = (bf16_t*)(F.ws + WS_CONV); bf16_t* ST = (bf16_t*)(F.ws + WS_STATES);
    const float* DT = (const float*)(F.ws + WS_DT); float* DTC = (float*)(F.ws + WS_DTC); float* CD = (float*)(F.ws + WS_CD);
    const int lane = F.lane, w = F.wave, tid = F.tid, r32 = lane & 31, hi = lane >> 5;
    for (int unit = F.vcu; unit < BATCH * NCH * 2; unit += F.G) {
        const int g = unit & 1, c = (unit >> 1) & 63, b = unit >> 7;
        const size_t r0 = (size_t)b * SEQ + c * 64;
        if (w < 6) {
            const int h = g * 6 + w; const size_t row = r0 + lane;
            const float dt = softplus_f(DT[row * 16 + h] + in[I_DTBIAS][h]);
            const float a = -expf(in[I_ALOG][h]);
            float cum = dt * a;
#pragma unroll
            for (int o = 1; o < 64; o <<= 1) { const float v = __shfl_up(cum, o); if (lane >= o) cum += v; }
            const float total = __shfl(cum, 63);
            ((LAS float*)(lds + S1_TOEND))[w * 64 + lane] = expf(total - cum) * dt;
            DTC[row * 24 + h * 2] = dt; DTC[row * 24 + h * 2 + 1] = cum;
            if (lane == 63) CD[((size_t)b * NCH + c) * 12 + h] = expf(total);
        }
        WG_BAR();
        if (tid < 320) {
            const int cg = tid % 80, tseg = tid / 80;
            int ch; if (cg < 48) ch = g * 384 + 8 * cg; else if (cg < 64) ch = 768 + g * 128 + 8 * (cg - 48); else ch = 1024 + g * 128 + 8 * (cg - 64);
            float wk[4][8], bias[8];
#pragma unroll
            for (int k = 0; k < 4; ++k) { const f32x4 a0 = *(const f32x4*)(in[I_CONVW] + k * SSM_CONV + ch), a1 = *(const f32x4*)(in[I_CONVW] + k * SSM_CONV + ch + 4);
                wk[k][0] = a0.x; wk[k][1] = a0.y; wk[k][2] = a0.z; wk[k][3] = a0.w; wk[k][4] = a1.x; wk[k][5] = a1.y; wk[k][6] = a1.z; wk[k][7] = a1.w; }
            { const f32x4 a0 = *(const f32x4*)(in[I_CONVB] + ch), a1 = *(const f32x4*)(in[I_CONVB] + ch + 4);
              bias[0] = a0.x; bias[1] = a0.y; bias[2] = a0.z; bias[3] = a0.w; bias[4] = a1.x; bias[5] = a1.y; bias[6] = a1.z; bias[7] = a1.w; }
            const int t0 = tseg * 16; const int pos0 = c * 64 + t0;
            const bf16_t* src = U + (r0 + t0) * NPROJ + 768 + ch;
            u32x4 win[3];
#pragma unroll
            for (int k = 0; k < 3; ++k) win[k] = (pos0 - 3 + k >= 0) ? *(const u32x4*)(src + (ptrdiff_t)(k - 3) * NPROJ) : (u32x4){0u, 0u, 0u, 0u};
#pragma unroll 4
            for (int tt = 0; tt < 16; ++tt) {
                const u32x4 cur = *(const u32x4*)(src + (size_t)tt * NPROJ);
                float o[8];
#pragma unroll
                for (int q = 0; q < 4; ++q) {
                    o[2 * q] = bias[2 * q] + wk[0][2 * q] * bflo(win[0][q]) + wk[1][2 * q] * bflo(win[1][q]) + wk[2][2 * q] * bflo(win[2][q]) + wk[3][2 * q] * bflo(cur[q]);
                    o[2 * q + 1] = bias[2 * q + 1] + wk[0][2 * q + 1] * bfhi(win[0][q]) + wk[1][2 * q + 1] * bfhi(win[1][q]) + wk[2][2 * q + 1] * bfhi(win[2][q]) + wk[3][2 * q + 1] * bfhi(cur[q]);
                }
#pragma unroll
                for (int q = 0; q < 8; ++q) o[q] = silu_f(o[q]);
                const int t = t0 + tt;
                u32x4 pk; pk.x = cvtpk(o[0], o[1]); pk.y = cvtpk(o[2], o[3]); pk.z = cvtpk(o[4], o[5]); pk.w = cvtpk(o[6], o[7]);
                *(u32x4*)(CONV + (r0 + t) * SSM_CONV + ch) = pk;
                if (cg < 48) { const float sc = ((const LAS float*)(lds + S1_TOEND))[(cg >> 3) * 64 + t]; const int lc = 8 * cg;
                    u32x4 ps; ps.x = cvtpk(o[0] * sc, o[1] * sc); ps.y = cvtpk(o[2] * sc, o[3] * sc); ps.z = cvtpk(o[4] * sc, o[5] * sc); ps.w = cvtpk(o[6] * sc, o[7] * sc);
                    *(LAS u32x4*)(lds + S1_XS + (lc >> 5) * 4096 + t * 64 + ((lc & 31) >> 3) * 16) = ps; }
                else if (cg < 64) { const int lc = 8 * (cg - 48); *(LAS u32x4*)(lds + S1_BM + (lc >> 5) * 4096 + t * 64 + ((lc & 31) >> 3) * 16) = pk; }
                win[0] = win[1]; win[1] = win[2]; win[2] = cur;
            }
        }
        WG_BAR();
        {
            const int lp = ((lane >> 4) & 1) * 32 + (lane & 3) * 8 + (4 * hi + ((lane & 15) >> 2)) * 64;
#pragma unroll 1
            for (int i = 0; i < 6; ++i) {
                const int k = w * 6 + i, hh = k >> 3, pb = (k >> 2) & 1, nb = k & 3;
                const LAS unsigned char* ap = lds + S1_XS + (hh * 2 + pb) * 4096 + lp; const LAS unsigned char* bp = lds + S1_BM + nb * 4096 + lp;
                f32x16 acc = (f32x16){};
#pragma unroll
                for (int ks = 0; ks < 4; ++ks) { const bf16x8 af = cat8(vtr(ap + ks * 1024), vtr(ap + ks * 1024 + 512)), bf = cat8(vtr(bp + ks * 1024), vtr(bp + ks * 1024 + 512));
                    acc = MFMA32(af, bf, acc); }
                bf16_t* dst = ST + (((size_t)b * NCH + c) * 12 + g * 6 + hh) * 8192 + (size_t)(32 * pb) * 128 + 32 * nb + r32;
#pragma unroll
                for (int r = 0; r < 16; ++r) dst[crow(r, hi) * 128] = (bf16_t)(cvtpk(acc[r], 0.f) & 0xffffu);
            }
        }
        WG_BAR();
    }
}

__device__ __forceinline__ void phase_ssd_scan(Frame& F) {
    const bf16_t* ST = (const bf16_t*)(F.ws + WS_STATES); bf16_t* HIN = (bf16_t*)(F.ws + WS_HIN); const float* CD = (const float*)(F.ws + WS_CD);
    for (int e = F.vcu * NTHREADS + F.tid; e < BATCH * 12 * 2048; e += F.G * NTHREADS) {
        const int b = e / 24576, rem = e - b * 24576, h = rem >> 11, pn = rem & 2047;
        float c0 = 0.f, c1 = 0.f, c2 = 0.f, c3 = 0.f;
#pragma unroll 8
        for (int c = 0; c < NCH; ++c) {
            const size_t o = (((size_t)b * NCH + c) * 12 + h) * 8192 + pn * 4;
            const u32x2 s = *(const u32x2*)(ST + o); const float d = CD[((size_t)b * NCH + c) * 12 + h];
            u32x2 hv; hv.x = cvtpk(c0, c1); hv.y = cvtpk(c2, c3); *(u32x2*)(HIN + o) = hv;
            c0 = c0 * d + bflo(s.x); c1 = c1 * d + bfhi(s.x); c2 = c2 * d + bflo(s.y); c3 = c3 * d + bfhi(s.y);
        }
    }
}

constexpr int S3_XI = 0, S3_ZI = 49152, S3_BI = 98304, S3_CI = 114688;
__device__ __forceinline__ void phase_ssd_out(Frame& F) {
    LAS unsigned char* lds = F.lds; const float* const* in = F.in;
    const bf16_t* U = (const bf16_t*)(F.ws + WS_U); const bf16_t* CONV = (const bf16_t*)(F.ws + WS_CONV); const bf16_t* HIN = (const bf16_t*)(F.ws + WS_HIN);
    const float* DTC = (const float*)(F.ws + WS_DTC); bf16_t* MIX = (bf16_t*)(F.ws + WS_MIX);
    const int lane = F.lane, w = F.wave, tid = F.tid, r32 = lane & 31, hi = lane >> 5, tb = w & 1, wq = w >> 1;
    const unsigned lds0 = (unsigned)(uintptr_t)lds;
    for (int unit = F.vcu; unit < BATCH * NCH * 2; unit += F.G) {
        const int g = unit & 1, c = (unit >> 1) & 63, b = unit >> 7;
        const size_t r0 = (size_t)b * SEQ + c * 64;
#pragma unroll 1
        for (int i = 0; i < 16; ++i) {
            const int pc = w * 16 + i;
            if (pc < 48) { const int blk = pc >> 2, rg = pc & 3; glds16(CONV + (r0 + 16 * rg + (lane >> 2)) * SSM_CONV + g * 384 + 32 * blk + 8 * (lane & 3), (unsigned)__builtin_amdgcn_readfirstlane(lds0 + S3_XI + pc * 1024)); }
            else if (pc < 96) { const int q = pc - 48, blk = q >> 2, rg = q & 3; glds16(U + (r0 + 16 * rg + (lane >> 2)) * NPROJ + g * 384 + 32 * blk + 8 * (lane & 3), (unsigned)__builtin_amdgcn_readfirstlane(lds0 + S3_ZI + q * 1024)); }
            else if (pc < 112) { const int q = pc - 96; glds16(CONV + (r0 + lane) * SSM_CONV + 768 + g * 128 + 8 * q, (unsigned)__builtin_amdgcn_readfirstlane(lds0 + S3_BI + q * 1024)); }
            else { const int q = pc - 112; glds16(CONV + (r0 + lane) * SSM_CONV + 1024 + g * 128 + 8 * q, (unsigned)__builtin_amdgcn_readfirstlane(lds0 + S3_CI + q * 1024)); }
        }
        if (w < 6) { const int h = g * 6 + w; const size_t row = r0 + lane;
            ((LAS float*)(lds + LC_DTS))[w * 64 + lane] = DTC[row * 24 + h * 2]; ((LAS float*)(lds + LC_CUM))[w * 64 + lane] = DTC[row * 24 + h * 2 + 1]; }
        if (tid < 384) ((LAS float*)(lds + LC_NG))[tid] = in[I_SSMNG][g * 384 + tid];
        WG_BAR();
        f32x16 cb[2]; cb[0] = (f32x16){}; cb[1] = (f32x16){};
        const LAS unsigned char* cpt = lds + S3_CI + hi * 1024 + (32 * tb + r32) * 16;
        {
            const LAS unsigned char* bpt = lds + S3_BI + hi * 1024 + r32 * 16;
#pragma unroll
            for (int kn = 0; kn < 8; ++kn) { const bf16x8 cf = *(const LAS bf16x8*)(cpt + kn * 2048);
                cb[0] = MFMA32(*(const LAS bf16x8*)(bpt + kn * 2048), cf, cb[0]); cb[1] = MFMA32(*(const LAS bf16x8*)(bpt + kn * 2048 + 512), cf, cb[1]); }
        }
        const int t = 32 * tb + r32;
        const int lp = ((lane >> 4) & 1) * 32 + (lane & 3) * 8 + (4 * hi + ((lane & 15) >> 2)) * 64;
        float ss = 0.f;
#pragma unroll 1
        for (int i = 0; i < 3; ++i) {
            const int pi = 3 * wq + i, hh = pi >> 1, pb = pi & 1, h = g * 6 + hh;
            const float cum_t = ((const LAS float*)(lds + LC_CUM))[hh * 64 + t];
            f32x16 acc = (f32x16){};
            const bf16_t* hp = HIN + (((size_t)b * NCH + c) * 12 + h) * 8192 + (size_t)(32 * pb + r32) * 128 + 8 * hi;
#pragma unroll
            for (int kn = 0; kn < 8; ++kn) acc = MFMA32(*(const bf16x8*)(hp + 16 * kn), *(const LAS bf16x8*)(cpt + kn * 2048), acc);
            const float et = expf(cum_t);
#pragma unroll
            for (int r = 0; r < 16; ++r) acc[r] *= et;
            u32x4 pw[4];
#pragma unroll
            for (int sb = 0; sb < 2; ++sb)
#pragma unroll
                for (int q = 0; q < 4; ++q) {
                    float wv[4];
#pragma unroll
                    for (int e = 0; e < 4; ++e) { const int r = 4 * q + e, s = 32 * sb + crow(r, hi);
                        const float cs = ((const LAS float*)(lds + LC_CUM))[hh * 64 + s], ds = ((const LAS float*)(lds + LC_DTS))[hh * 64 + s];
                        wv[e] = (s <= t) ? cb[sb][r] * expf(cum_t - cs) * ds : 0.f; }
                    pw[2 * sb + (q >> 1)][(q & 1) * 2] = cvtpk(wv[0], wv[1]); pw[2 * sb + (q >> 1)][(q & 1) * 2 + 1] = cvtpk(wv[2], wv[3]);
                }
            const LAS unsigned char* xp = lds + S3_XI + (hh * 2 + pb) * 4096 + lp;
#pragma unroll
            for (int ks = 0; ks < 4; ++ks) acc = MFMA32(cat8(vtr(xp + ks * 1024), vtr(xp + ks * 1024 + 512)), __builtin_bit_cast(bf16x8, pw[ks]), acc);
            const float dsk = in[I_SSMD][h];
            const LAS unsigned char* xr = lds + S3_XI + (hh * 2 + pb) * 4096 + t * 64 + 8 * hi; LAS unsigned char* zr = lds + S3_ZI + (hh * 2 + pb) * 4096 + t * 64 + 8 * hi;
#pragma unroll
            for (int q = 0; q < 4; ++q) { const u32x2 xv = *(const LAS u32x2*)(xr + 16 * q), zv = *(const LAS u32x2*)(zr + 16 * q);
                const float v0 = (acc[4 * q] + dsk * bflo(xv.x)) * silu_f(bflo(zv.x)), v1 = (acc[4 * q + 1] + dsk * bfhi(xv.x)) * silu_f(bfhi(zv.x));
                const float v2 = (acc[4 * q + 2] + dsk * bflo(xv.y)) * silu_f(bflo(zv.y)), v3 = (acc[4 * q + 3] + dsk * bfhi(xv.y)) * silu_f(bfhi(zv.y));
                ss += (v0 * v0 + v1 * v1) + (v2 * v2 + v3 * v3);
                u32x2 yv; yv.x = cvtpk(v0, v1); yv.y = cvtpk(v2, v3); *(LAS u32x2*)(zr + 16 * q) = yv; }
        }
        ss += __shfl_xor(ss, 32);
        if (hi == 0) ((LAS float*)(lds + LC_PART))[wq * 64 + t] = ss;
        WG_BAR();
        { const LAS float* pp = (const LAS float*)(lds + LC_PART); const float tot = (pp[t] + pp[64 + t]) + (pp[128 + t] + pp[192 + t]);
          const float rs = 1.0f / sqrtf(tot * (1.0f / 384.0f) + EPS);
          bf16_t* orow = MIX + (r0 + t) * DM + g * 384;
#pragma unroll 1
          for (int i = 0; i < 3; ++i) { const int pi = 3 * wq + i, hh = pi >> 1, pb = pi & 1;
              const LAS unsigned char* zr = lds + S3_ZI + (hh * 2 + pb) * 4096 + t * 64 + 8 * hi;
#pragma unroll
              for (int q = 0; q < 4; ++q) { const int lc = 64 * hh + 32 * pb + 8 * q + 4 * hi; const f32x4 gg = *(const LAS f32x4*)(lds + LC_NG + lc * 4);
                  const u32x2 yv = *(const LAS u32x2*)(zr + 16 * q);
                  u32x2 wv; wv.x = cvtpk(bflo(yv.x) * rs * gg.x, bfhi(yv.x) * rs * gg.y); wv.y = cvtpk(bflo(yv.y) * rs * gg.z, bfhi(yv.y) * rs * gg.w);
                  *(u32x2*)(orow + lc) = wv; } } }
        WG_BAR();
    }
}

constexpr int LC_LCNT = MISC_OFF + 128;
__device__ __forceinline__ void phase_route(Frame& F) {
    const float* const* in = F.in; LAS unsigned char* lds = F.lds;
    unsigned char* XNM = F.ws + WS_XNM; i32x4* ROUTE = (i32x4*)(F.ws + WS_ROUTE); f32x2* GATE = (f32x2*)(F.ws + WS_GATE);
    const int lane = F.lane, w = F.wave;
    const float* g = in[I_LN2G] + DM; const float* Wr = in[I_ROUTER];
    for (int blk = F.vcu; blk < T / 64; blk += F.G) {
        if (F.tid < 8) ((LAS int*)(lds + LC_LCNT))[F.tid] = 0;
        WG_BAR();
#pragma unroll 1
        for (int i = 0; i < 8; ++i) {
            const size_t row = (size_t)blk * 64 + w * 8 + i;
            const GAS f32x4* xr = (const GAS f32x4*)(F.out + row * DM) + lane; const GAS f32x4* gr = (const GAS f32x4*)g + lane;
            f32x4 v[4]; float s = 0.f;
#pragma unroll
            for (int j = 0; j < 4; ++j) { v[j] = xr[64 * j]; s += (v[j].x * v[j].x + v[j].y * v[j].y) + (v[j].z * v[j].z + v[j].w * v[j].w); }
            const float rstd = 1.0f / sqrtf(wave_sum(s) * (1.f / DM) + EPS);
            float lg[8];
#pragma unroll
            for (int e = 0; e < 8; ++e) lg[e] = 0.f;
            GAS unsigned* o8 = (GAS unsigned*)(XNM + row * DM) + lane;
#pragma unroll
            for (int j = 0; j < 4; ++j) { const f32x4 gg = gr[64 * j]; const f32x4 hn = {v[j].x * rstd * gg.x, v[j].y * rstd * gg.y, v[j].z * rstd * gg.z, v[j].w * rstd * gg.w};
                o8[64 * j] = pack4_fp8(hn.x, hn.y, hn.z, hn.w);
                const float* wp = Wr + (size_t)(256 * j + 4 * lane) * 8;
#pragma unroll
                for (int q = 0; q < 4; ++q) { const f32x4 w0 = *(const f32x4*)(wp + 8 * q), w1 = *(const f32x4*)(wp + 8 * q + 4); const float hq = hn[q];
                    lg[0] += hq * w0.x; lg[1] += hq * w0.y; lg[2] += hq * w0.z; lg[3] += hq * w0.w; lg[4] += hq * w1.x; lg[5] += hq * w1.y; lg[6] += hq * w1.z; lg[7] += hq * w1.w; } }
#pragma unroll
            for (int e = 0; e < 8; ++e) lg[e] = wave_sum(lg[e]);
            int e0 = 0; float v0 = lg[0];
#pragma unroll
            for (int e = 1; e < 8; ++e) if (lg[e] > v0) { v0 = lg[e]; e0 = e; }
            int e1 = -1; float v1 = -3.0e38f;
#pragma unroll
            for (int e = 0; e < 8; ++e) if (e != e0 && lg[e] > v1) { v1 = lg[e]; e1 = e; }
            if (lane == 0) {
                const float g0 = 1.0f / (1.0f + expf(v1 - v0));
                const int lr0 = __hip_atomic_fetch_add((LAS int*)(lds + LC_LCNT) + e0, 1, __ATOMIC_RELAXED, __HIP_MEMORY_SCOPE_WORKGROUP), lr1 = __hip_atomic_fetch_add((LAS int*)(lds + LC_LCNT) + e1, 1, __ATOMIC_RELAXED, __HIP_MEMORY_SCOPE_WORKGROUP);
                ROUTE[row] = (i32x4){e0, lr0, e1, lr1}; GATE[row] = (f32x2){g0, 1.0f - g0};
            }
        }
        WG_BAR();
        if (F.tid < 8) F.ctl[CW_CNT + blk * 8 + F.tid] = (unsigned)((LAS int*)(lds + LC_LCNT))[F.tid];
        WG_BAR();
    }
}
__device__ __forceinline__ void phase_gather(Frame& F) {
    LAS unsigned char* lds = F.lds;
    const unsigned char* XNM = F.ws + WS_XNM; unsigned char* HP = F.ws + WS_HPERM; i32x4* ROUTE = (i32x4*)(F.ws + WS_ROUTE);
    const int lane = F.lane, w = F.wave;
    for (int blk = F.vcu; blk < T / 64; blk += F.G) {
        { int tot = 0, pre = 0;
#pragma unroll
          for (int k = 0; k < 4; ++k) { const int bi = lane + 64 * k; const int cnt = (int)F.ctl[CW_CNT + bi * 8 + w]; tot += cnt; pre += (bi < blk) ? cnt : 0; }
#pragma unroll
          for (int o = 1; o < 64; o <<= 1) { tot += __shfl_xor(tot, o); pre += __shfl_xor(pre, o); }
          if (lane == 0) { ((LAS int*)(lds + LC_LCNT))[8 + w] = tot; ((LAS int*)(lds + LC_LCNT))[16 + w] = pre; } }
        WG_BAR();
        int base[8], off[9]; off[0] = 0;
#pragma unroll
        for (int e = 0; e < 8; ++e) { const int tot = ((LAS int*)(lds + LC_LCNT))[8 + e]; off[e + 1] = off[e] + ((tot + 255) & ~255); base[e] = off[e] + ((LAS int*)(lds + LC_LCNT))[16 + e]; }
#pragma unroll 1
        for (int i = 0; i < 8; ++i) {
            const size_t row = (size_t)blk * 64 + w * 8 + i;
            const i32x4 rt = ROUTE[row];
            int s0 = rt.y, s1 = rt.w;
#pragma unroll
            for (int e = 0; e < 8; ++e) { if (rt.x == e) s0 += base[e]; if (rt.z == e) s1 += base[e]; }
            const u32x4 a = *((const u32x4*)(XNM + row * DM) + lane);
            *((u32x4*)(HP + (size_t)s0 * DM) + lane) = a; *((u32x4*)(HP + (size_t)s1 * DM) + lane) = a;
            if (lane == 0) ROUTE[row] = (i32x4){s0, s1, 0, 0};
        }
        if (blk < 8) {
            const int e = blk; int tot = ((LAS int*)(lds + LC_LCNT))[8 + e]; int lo = 0, hi_ = 0;
#pragma unroll
            for (int q = 0; q < 8; ++q) if (q == e) { lo = off[q] + tot; hi_ = off[q + 1]; }
            for (int r = lo + (F.tid >> 6); r < hi_; r += 8) *((u32x4*)(HP + (size_t)r * DM) + (F.tid & 63)) = (u32x4){0u, 0u, 0u, 0u};
            if (blk == 0 && F.tid == 0) {
                F.ctl[CW_NTILES] = (unsigned)(off[8] >> 8);
#pragma unroll
                for (int q = 0; q < 8; ++q) for (int tix = off[q] >> 8; tix < (off[q + 1] >> 8); ++tix) F.ctl[CW_TILE_E + tix] = (unsigned)q;
            }
        }
        WG_BAR();
    }
}
__device__ __forceinline__ void phase_combine(Frame& F) {
    const bf16_t* Y = (const bf16_t*)(F.ws + WS_Y); const i32x4* ROUTE = (const i32x4*)(F.ws + WS_ROUTE); const f32x2* GATE = (const f32x2*)(F.ws + WS_GATE);
    const int gw = F.vcu * NWAVES + F.wave, NGW = F.G * NWAVES, lane = F.lane;
    for (int m = gw; m < T; m += NGW) {
        const i32x4 rt = ROUTE[m]; const f32x2 gt = GATE[m];
        GAS f32x4* o = (GAS f32x4*)(F.out + (size_t)m * DM) + lane;
        const GAS u32x2* y0 = (const GAS u32x2*)(Y + (size_t)rt.x * DM) + lane; const GAS u32x2* y1 = (const GAS u32x2*)(Y + (size_t)rt.y * DM) + lane;
#pragma unroll
        for (int j = 0; j < 4; ++j) { f32x4 v = o[64 * j]; const u32x2 a = y0[64 * j], c = y1[64 * j];
            v.x += gt.x * bflo(a.x) + gt.y * bflo(c.x); v.y += gt.x * bfhi(a.x) + gt.y * bfhi(c.x); v.z += gt.x * bflo(a.y) + gt.y * bflo(c.y); v.w += gt.x * bfhi(a.y) + gt.y * bfhi(c.y);
            o[64 * j] = v; }
    }
}

constexpr int NPH_ALL = 18;
constexpr int NPH = (MK_LEVEL == 0) ? 1 : (MK_LEVEL == 1) ? 4 : (MK_LEVEL == 2) ? 7 : (MK_LEVEL == 3) ? 13 : NPH_ALL;
struct Args { const float* in[N_IN]; float* out; unsigned char* ws; int ph_lo, ph_hi; };
static_assert(sizeof(Args) == N_IN * 8 + 24, "Args has no padding");

__global__ void __launch_bounds__(NTHREADS, 2) fwd(Args a) {
    extern __shared__ __attribute__((aligned(16))) unsigned char lds_raw[];
    Frame F;
    F.lds = (LAS unsigned char*)lds_raw;
    F.tid = threadIdx.x; F.lane = F.tid & 63; F.wave = __builtin_amdgcn_readfirstlane(F.tid >> 6);
    F.G = gridDim.x; { const int bx = blockIdx.x; F.vcu = (F.G % 8 == 0) ? (bx % 8) * (F.G / 8) + bx / 8 : bx; }
    F.ws = a.ws; F.ctl = (gu32*)(a.ws + WS_CTL); F.in = a.in; F.out = a.out;
    for (int u = F.tid; u < (LDS_BYTES - MISC_OFF) / 4; u += NTHREADS) ((LAS unsigned*)(F.lds + MISC_OFF))[u] = 0u;
    __syncthreads();
#if MK_ONE_LAUNCH
    XcdBarrier bar = xcd_barrier_post((unsigned*)(F.ctl + CW_BAR), (volatile LAS unsigned*)(F.lds + MISC_OFF + 32));
#define GRID_BAR() xcd_barrier(bar)
#else
#define GRID_BAR() do {} while (0)
#endif
    const int lo = a.ph_lo, hi = a.ph_hi;
#define IN(k) ((k) < NPH && lo <= (k) && (k) < hi)
#define SEAM(k) do { PROBE_END(k); if (IN(k) && IN((k) + 1)) GRID_BAR(); PROBE_BEGIN((k) + 1); } while (0)
    unsigned long long pr_t0 = 0;
#define PROBE_BEGIN(k) do { if (MK_PROBE_LO == (k)) pr_t0 = __builtin_amdgcn_s_memrealtime(); } while (0)
#define PROBE_END(k) do { if (MK_PROBE_HI == (k)) { const unsigned long long t1_ = __builtin_amdgcn_s_memrealtime(), d_ = (t1_ - pr_t0) * MK_PROBE_MULT; while (__builtin_amdgcn_s_memrealtime() - t1_ < d_) __builtin_amdgcn_s_sleep(16); } } while (0)
    PROBE_BEGIN(0);
    unsigned char* ws = a.ws;
    const int cidx = (int)blockIdx.x;

    if (IN(0)) { phase_prologue(F); } SEAM(0);

    if (IN(1)) {
        lds_load_vec64(F, LC_QG, F.in[I_DAQNG]); lds_load_vec64(F, LC_KG, F.in[I_DAKNG]); lds_load_vec64(F, LC_MQG, F.in[I_MQNG]);
        lds_load_vec64(F, LC_MKG0, F.in[I_MKNG]); lds_load_vec64(F, LC_MKG1, F.in[I_MKNG] + 64);
        WG_BAR();
        SchedP1 S; S.so.init(T, NPROJ, F.G, cidx); S.ws = (const char*)ws;
        EpiProj<CfgP1> E{CfgP1{(bf16_t*)(ws + WS_U), (bf16_t*)(ws + WS_KVM)}, F.lds};
        pg8::gemm_phase<EpiProj<CfgP1>, SchedP1, true, true>(F.lds, DM, S, E);
    } SEAM(1);

    if (IN(2)) { phase_attn0(F); } SEAM(2);

    if (IN(3)) {
        SchedPlain S; S.init(T, DM, F.G, cidx); S.A = (const char*)(ws + WS_MIX); S.B = (const char*)(ws + WS_WOUT0); S.ta = 256 * DM * 2; S.tb = 256 * DM * 2;
        EpiResid E{F.in[I_X], F.out};
        pg8::gemm_phase<EpiResid, SchedPlain, true, true>(F.lds, DM, S, E);
    } SEAM(3);

    if (IN(4)) { phase_rownorm(F, F.in[I_LN2G], (bf16_t*)(ws + WS_XN)); } SEAM(4);

    if (IN(5)) {
        SchedPlain S; S.init(T, 2 * FFN, F.G, cidx); S.A = (const char*)(ws + WS_XN); S.B = (const char*)(ws + WS_WGU); S.ta = 256 * DM * 2; S.tb = 256 * DM * 2;
        EpiSwiGLU<false> E{(void*)(ws + WS_ACT), FFN, 1.0f, 1.0f};
        pg8::gemm_phase<EpiSwiGLU<false>, SchedPlain, true, true>(F.lds, DM, S, E);
    } SEAM(5);

    if (IN(6)) {
        SchedPlain S; S.init(T, DM, F.G, cidx); S.A = (const char*)(ws + WS_ACT); S.B = (const char*)(ws + WS_WDN); S.ta = (size_t)256 * FFN * 2; S.tb = (size_t)256 * FFN * 2;
        EpiResid E{F.out, F.out};
        pg8::gemm_phase<EpiResid, SchedPlain, true, true>(F.lds, FFN, S, E);
    } SEAM(6);

    if (IN(7)) { phase_rownorm(F, F.in[I_LN1G] + DM, (bf16_t*)(ws + WS_XN)); } SEAM(7);

    if (IN(8)) {
        lds_load_vec64(F, LC_MQG, F.in[I_MQNG] + 64);
        WG_BAR();
        SchedPlain S; S.init(T, NPROJ, F.G, cidx); S.A = (const char*)(ws + WS_XN); S.B = (const char*)(ws + WS_WSSM); S.ta = 256 * DM * 2; S.tb = 256 * DM * 2;
        EpiProj<CfgP8> E{CfgP8{(bf16_t*)(ws + WS_U), (float*)(ws + WS_DT)}, F.lds};
        pg8::gemm_phase<EpiProj<CfgP8>, SchedPlain, true, true>(F.lds, DM, S, E);
    } SEAM(8);

    if (IN(9)) { phase_ssd_local(F); phase_memattn1(F); } SEAM(9);
    if (IN(10)) { phase_ssd_scan(F); } SEAM(10);
    if (IN(11)) { phase_ssd_out(F); } SEAM(11);

    if (IN(12)) {
        SchedPlain S; S.init(T, DM, F.G, cidx); S.A = (const char*)(ws + WS_MIX); S.B = (const char*)(ws + WS_WOUT1); S.ta = 256 * DM * 2; S.tb = 256 * DM * 2;
        EpiResid E{F.out, F.out};
        pg8::gemm_phase<EpiResid, SchedPlain, true, true>(F.lds, DM, S, E);
    } SEAM(12);

    if (IN(13)) { phase_route(F); } SEAM(13);
    if (IN(14)) { phase_gather(F); } SEAM(14);

    if (IN(15)) {
        const int ntiles = (int)F.ctl[CW_NTILES];
        SchedMoe S; S.init(ntiles * 256, 2 * EXD, F.G, cidx); S.A = (const char*)(ws + WS_HPERM); S.B = (const char*)(ws + WS_WMGU); S.ta = 256 * DM; S.tb = 256 * DM; S.eb = (size_t)2 * EXD * DM;
        S.tile_e = (const int*)(const unsigned*)(F.ctl + CW_TILE_E);
        EpiSwiGLU<true> E{(void*)(ws + WS_ACTM), EXD, 1.0f / W8_SCALE, ACT8_SCALE};
        pg8::gemm_phase<EpiSwiGLU<true>, SchedMoe, true, true, true>(F.lds, DM, S, E);
    } SEAM(15);

    if (IN(16)) {
        const int ntiles = (int)F.ctl[CW_NTILES];
        SchedMoe S; S.init(ntiles * 256, DM, F.G, cidx); S.A = (const char*)(ws + WS_ACTM); S.B = (const char*)(ws + WS_WMDN); S.ta = (size_t)256 * EXD; S.tb = (size_t)256 * EXD; S.eb = (size_t)DM * EXD;
        S.tile_e = (const int*)(const unsigned*)(F.ctl + CW_TILE_E);
        EpiBf16 E{(bf16_t*)(ws + WS_Y), DM, 1.0f / (W8_SCALE * ACT8_SCALE)};
        pg8::gemm_phase<EpiBf16, SchedMoe, true, true, true>(F.lds, EXD, S, E);
    } SEAM(16);

    if (IN(17)) { phase_combine(F); }
    PROBE_END(17);
#undef IN
#undef SEAM
}

extern "C" void kernel_launch(void* const* d_in, const int* in_sizes, int n_in, void* d_out, int out_size, void* d_ws, size_t ws_size, hipStream_t stream) {
    static int grid = 0;
    if (grid == 0) {
        if (n_in != N_IN || out_size != T * DM || ws_size < WS_END) { fprintf(stderr, "kernel_launch: unexpected problem shape (n_in %d, out %d, ws %zu)\n", n_in, out_size, ws_size); grid = -1; return; }
        int dev = 0, cus = 0, per_cu = 0;
        if (hipGetDevice(&dev) != hipSuccess || hipDeviceGetAttribute(&cus, hipDeviceAttributeMultiprocessorCount, dev) != hipSuccess) { grid = -1; return; }
        if (hipFuncSetAttribute((const void*)fwd, hipFuncAttributeMaxDynamicSharedMemorySize, LDS_BYTES) != hipSuccess) { fprintf(stderr, "kernel_launch: hipFuncSetAttribute failed\n"); grid = -1; return; }
        if (hipOccupancyMaxActiveBlocksPerMultiprocessor(&per_cu, (const void*)fwd, NTHREADS, LDS_BYTES) != hipSuccess || per_cu < 1) fprintf(stderr, "kernel_launch: occupancy query reports %d\n", per_cu);
        (void)hipGetLastError();
        grid = cus;
    }
    if (grid < 0) return;
    if (hipMemsetAsync((char*)d_ws + WS_CTL, 0, CTL_ZERO_BYTES, stream) != hipSuccess) return;
    Args a{};
    for (int i = 0; i < N_IN; ++i) a.in[i] = (const float*)d_in[i];
    a.out = (float*)d_out; a.ws = (unsigned char*)d_ws;
#if MK_ONE_LAUNCH
    a.ph_lo = 0; a.ph_hi = NPH;
    hipLaunchKernelGGL(fwd, dim3(grid), dim3(NTHREADS), LDS_BYTES, stream, a);
#else
    for (int p = 0; p < NPH; ++p) { a.ph_lo = p; a.ph_hi = p + 1; hipLaunchKernelGGL(fwd, dim3(grid), dim3(NTHREADS), LDS_BYTES, stream, a); }
#endif
}
```
